# Optimizing an MI355X kernel written in HIP

```python
import math
import jax, jax.numpy as jnp
from jax import lax
import numpy as np

D_MODEL = 2048
BATCH = 2
SEQ = 4096
DEPTH = 1

CHUNK = 64
BLK = 128
HEAD_DIM = 64
A_HEADS = 16
A_KV_HEADS = 2
A_REP = A_HEADS // A_KV_HEADS
WINDOW = 128
WIN_CHUNKS = WINDOW // CHUNK
B_HEADS = 16
A_WIDTH = A_HEADS * HEAD_DIM
A_KV_WIDTH = A_KV_HEADS * HEAD_DIM
B_WIDTH = B_HEADS * HEAD_DIM
IN_SIZES = (A_WIDTH, A_KV_WIDTH, A_KV_WIDTH, B_WIDTH, B_WIDTH, B_WIDTH, D_MODEL, D_MODEL)
N_IN = sum(IN_SIZES)
IN_CUTS = tuple(int(c) for c in np.cumsum(IN_SIZES)[:-1])
REL_BUCKETS = 32
REL_MAX_DIST = 128
MEM_LEN = 256
X_HEADS = 4
X_HEAD_DIM = D_MODEL // X_HEADS
N_EXPERTS = 32
TOP_K = 4
D_FF = D_MODEL
SWIGLU_LIMIT = 7.0
SWIGLU_ALPHA = 1.702
EXPERT_BLOCK = 128
LN_EPS = 1e-5
DEEPNORM_ALPHA = (2.0 * DEPTH) ** 0.25
DEEPNORM_BETA = (8.0 * DEPTH) ** -0.25

kernel_name = "hybrid_swa_stickbreaking_moe_streaming_block"


def layer_norm(x, g, b):
    xf = x.astype(jnp.float32)
    mu = xf.mean(-1, keepdims=True)
    var = jnp.square(xf - mu).mean(-1, keepdims=True)
    y = (xf - mu) * lax.rsqrt(var + LN_EPS)
    return (y * g.astype(jnp.float32) + b.astype(jnp.float32)).astype(x.dtype)


def t5_bucket(rel):
    half = REL_BUCKETS // 2
    max_exact = half // 2
    base = jnp.where(rel > 0, half, 0)
    n = jnp.abs(rel)
    nf = jnp.maximum(n, 1).astype(jnp.float32)
    large = max_exact + (jnp.log(nf / max_exact) / math.log(REL_MAX_DIST / max_exact)
                         * (half - max_exact)).astype(jnp.int32)
    large = jnp.minimum(large, half - 1)
    return base + jnp.where(n < max_exact, n, large)


def sliding_window_attn(q, k, v, sinks, rel_bias):
    b_, s_ = q.shape[0], q.shape[1]
    nb = s_ // BLK
    qb = q.reshape(b_, nb, BLK, A_KV_HEADS, A_REP, HEAD_DIM)
    kb = k.reshape(b_, nb, BLK, A_KV_HEADS, HEAD_DIM)
    vb = v.reshape(b_, nb, BLK, A_KV_HEADS, HEAD_DIM)

    def with_prev(t):
        prev = jnp.concatenate([jnp.zeros_like(t[:, :1]), t[:, :-1]], axis=1)
        return jnp.concatenate([prev, t], axis=2)

    kk, vv = with_prev(kb), with_prev(vb)
    logits = jnp.einsum('bnqgrd,bnkgd->bngrqk', qb, kk).astype(jnp.float32) * (HEAD_DIM ** -0.5)
    qi = jnp.arange(BLK)[:, None]
    kj = jnp.arange(2 * BLK)[None, :]
    bias = rel_bias[t5_bucket(kj - BLK - qi)]
    bias = jnp.transpose(bias, (2, 0, 1)).reshape(A_KV_HEADS, A_REP, BLK, 2 * BLK).astype(jnp.float32)
    dchunk = (kj // CHUNK - BLK // CHUNK) - qi // CHUNK
    band = (dchunk <= 0) & (dchunk >= -WIN_CHUNKS)
    key_exists = (jnp.arange(nb)[:, None] > 0) | (jnp.arange(2 * BLK)[None, :] >= BLK)
    mask = band[None] & key_exists[:, None, :]
    logits = jnp.where(mask[None, :, None, None], logits + bias, -jnp.inf)
    sink = sinks.astype(jnp.float32).reshape(1, 1, A_KV_HEADS, A_REP, 1, 1)
    m = jnp.maximum(logits.max(-1, keepdims=True), sink)
    p = jnp.exp(logits - m)
    p = p / (p.sum(-1, keepdims=True) + jnp.exp(sink - m))
    out = jnp.einsum('bngrqk,bnkgd->bnqgrd', p.astype(v.dtype), vv)
    return out.reshape(b_, s_, A_WIDTH)


def stick_breaking_attn(q, k, v):
    b_, s_ = q.shape[0], q.shape[1]
    nb = s_ // BLK
    qb = jnp.moveaxis(q.reshape(b_, nb, BLK, B_HEADS, HEAD_DIM), 1, 0)
    starts = jnp.arange(nb) * BLK
    key_pos = jnp.arange(s_)
    scale = HEAD_DIM ** -0.5

    def block(args):
        qblk, start = args
        z = jnp.einsum('bqhd,bkhd->bhqk', qblk, k).astype(jnp.float32) * scale
        causal = key_pos[None, :] < (start + jnp.arange(BLK))[:, None]
        log_keep = jnp.where(causal, jax.nn.log_sigmoid(-z), 0.0)
        suffix = lax.cumsum(log_keep, axis=3, reverse=True)
        log_w = jax.nn.log_sigmoid(z) + (suffix - log_keep)
        w = jnp.where(causal, jnp.exp(log_w), 0.0).astype(v.dtype)
        return jnp.einsum('bhqk,bkhd->bqhd', w, v)

    out = lax.map(block, (qb, starts))
    return jnp.moveaxis(out, 0, 1).reshape(b_, s_, B_WIDTH)


def memory_cross_attn(h, mem, w_q, w_kv, w_o):
    b_, s_, _ = h.shape
    q = (h @ w_q).reshape(b_, s_, X_HEADS, X_HEAD_DIM)
    k, v = jnp.split(mem @ w_kv, 2, axis=-1)
    k = k.reshape(b_, MEM_LEN, X_HEADS, X_HEAD_DIM)
    v = v.reshape(b_, MEM_LEN, X_HEADS, X_HEAD_DIM)
    logits = jnp.einsum('bqhd,bkhd->bhqk', q, k).astype(jnp.float32) * (X_HEAD_DIM ** -0.5)
    p = jax.nn.softmax(logits, axis=-1).astype(v.dtype)
    o = jnp.einsum('bhqk,bkhd->bqhd', p, v).reshape(b_, s_, D_MODEL)
    return o @ w_o


def moe_ffn(x2d, w_router, b_router, w_up, b_up, w_down, b_down):
    t_ = x2d.shape[0]
    logits = (x2d @ w_router + b_router).astype(jnp.float32)
    top_val, top_idx = lax.top_k(logits, TOP_K)
    gate = jax.nn.softmax(top_val, axis=-1)
    n_pairs = t_ * TOP_K
    pair_expert = top_idx.reshape(n_pairs)
    pair_token = jnp.arange(n_pairs) // TOP_K
    pair_gate = gate.reshape(n_pairs)
    order = jnp.argsort(pair_expert)
    sorted_e = pair_expert[order]
    counts = jnp.zeros((N_EXPERTS,), jnp.int32).at[pair_expert].add(1)
    padded = (counts + EXPERT_BLOCK - 1) // EXPERT_BLOCK * EXPERT_BLOCK
    offset = jnp.cumsum(counts) - counts
    pad_end = jnp.cumsum(padded)
    pad_offset = pad_end - padded
    dest = pad_offset[sorted_e] + (jnp.arange(n_pairs) - offset[sorted_e])
    n_rows = n_pairs + N_EXPERTS * EXPERT_BLOCK
    n_blocks = n_rows // EXPERT_BLOCK
    row_pair = jnp.zeros((n_rows,), jnp.int32).at[dest].set(order.astype(jnp.int32))
    row_valid = jnp.zeros((n_rows,), bool).at[dest].set(True)
    row_token = pair_token[row_pair]
    row_gate = jnp.where(row_valid, pair_gate[row_pair], 0.0)
    block_expert = jnp.minimum(
        jnp.searchsorted(pad_end, jnp.arange(n_blocks) * EXPERT_BLOCK, side='right'), N_EXPERTS - 1)

    def expert_block(args):
        tok, e = args
        hid = x2d[tok] @ w_up[e] + b_up[e]
        glu, lin = hid[:, :D_FF], hid[:, D_FF:]
        glu = jnp.minimum(glu, SWIGLU_LIMIT)
        lin = jnp.clip(lin, -SWIGLU_LIMIT, SWIGLU_LIMIT)
        act = glu * jax.nn.sigmoid(SWIGLU_ALPHA * glu) * (lin + 1.0)
        return act @ w_down[e] + b_down[e]

    y_rows = lax.map(expert_block, (row_token.reshape(n_blocks, EXPERT_BLOCK), block_expert))
    y_rows = y_rows.reshape(n_rows, D_MODEL)
    return jnp.zeros_like(x2d).at[row_token].add(y_rows * row_gate[:, None].astype(y_rows.dtype))


def setup_inputs(seed: int = 0) -> dict:
    key = jax.random.key(seed)
    ks = jax.random.split(key, 26)
    f32 = jnp.float32

    def nrm(k, shape, scale):
        return jax.random.normal(k, shape, f32) * scale

    L, D, F, G = DEPTH, D_MODEL, D_FF, N_EXPERTS
    beta = DEEPNORM_BETA
    return {
        "x": nrm(ks[0], (BATCH, SEQ, D), 1.0),
        "mem": nrm(ks[1], (BATCH, MEM_LEN, D), 1.0),
        "ln_in_g": 1.0 + nrm(ks[2], (D,), 0.02),
        "ln_in_b": nrm(ks[3], (D,), 0.02),
        "rel_bias": nrm(ks[4], (REL_BUCKETS, A_HEADS), 0.5),
        "w_in": nrm(ks[5], (L, D, N_IN), D ** -0.5),
        "b_in": nrm(ks[6], (L, N_IN), 0.02),
        "attn_sinks": nrm(ks[7], (L, A_HEADS), 0.5),
        "w_a_out": nrm(ks[8], (L, A_WIDTH, D), A_WIDTH ** -0.5),
        "w_b_out": nrm(ks[9], (L, B_WIDTH, D), B_WIDTH ** -0.5),
        "w_mix_out": nrm(ks[10], (L, D, D), beta * D ** -0.5),
        "ln1_g": 1.0 + nrm(ks[11], (L, D), 0.02),
        "ln1_b": nrm(ks[12], (L, D), 0.02),
        "w_xq": nrm(ks[13], (L, D, D), D ** -0.5),
        "w_xkv": nrm(ks[14], (L, D, 2 * D), D ** -0.5),
        "w_xo": nrm(ks[15], (L, D, D), beta * D ** -0.5),
        "ln2_g": 1.0 + nrm(ks[16], (L, D), 0.02),
        "ln2_b": nrm(ks[17], (L, D), 0.02),
        "w_router": nrm(ks[18], (L, D, G), D ** -0.5),
        "b_router": nrm(ks[19], (L, G), 0.01),
        "w_up": nrm(ks[20], (L, G, D, 2 * F), D ** -0.5),
        "b_up": nrm(ks[21], (L, G, 2 * F), 0.02),
        "w_down": nrm(ks[22], (L, G, F, D), beta * F ** -0.5),
        "b_down": nrm(ks[23], (L, G, D), 0.02),
        "ln3_g": 1.0 + nrm(ks[24], (L, D), 0.02),
        "ln3_b": nrm(ks[25], (L, D), 0.02),
    }


def reference(x, mem, ln_in_g, ln_in_b, rel_bias, w_in, b_in, attn_sinks, w_a_out, w_b_out,
              w_mix_out, ln1_g, ln1_b, w_xq, w_xkv, w_xo, ln2_g, ln2_b, w_router, b_router,
              w_up, b_up, w_down, b_down, ln3_g, ln3_b):
    b_, s_, _ = x.shape
    h = layer_norm(x, ln_in_g, ln_in_b)
    for l in range(DEPTH):
        proj = h @ w_in[l] + b_in[l]
        qa, ka, va, qb, kb, vb, ga, gb = jnp.split(proj, IN_CUTS, axis=-1)
        ya = sliding_window_attn(qa.reshape(b_, s_, A_HEADS, HEAD_DIM),
                                 ka.reshape(b_, s_, A_KV_HEADS, HEAD_DIM),
                                 va.reshape(b_, s_, A_KV_HEADS, HEAD_DIM),
                                 attn_sinks[l], rel_bias) @ w_a_out[l]
        yb = stick_breaking_attn(qb.reshape(b_, s_, B_HEADS, HEAD_DIM),
                                 kb.reshape(b_, s_, B_HEADS, HEAD_DIM),
                                 vb.reshape(b_, s_, B_HEADS, HEAD_DIM)) @ w_b_out[l]
        mixed = (jax.nn.sigmoid(ga) * ya + jax.nn.sigmoid(gb) * yb) @ w_mix_out[l]
        h = layer_norm(DEEPNORM_ALPHA * h + mixed, ln1_g[l], ln1_b[l])
        xo = memory_cross_attn(h, mem, w_xq[l], w_xkv[l], w_xo[l])
        h = layer_norm(DEEPNORM_ALPHA * h + xo, ln2_g[l], ln2_b[l])
        ff = moe_ffn(h.reshape(b_ * s_, D_MODEL), w_router[l], b_router[l],
                     w_up[l], b_up[l], w_down[l], b_down[l]).reshape(b_, s_, D_MODEL)
        h = layer_norm(DEEPNORM_ALPHA * h + ff, ln3_g[l], ln3_b[l])
    return h
```

```cpp
#include <hip/hip_runtime.h>
#include <cstdio>
#include <cstdint>
namespace pg8 {
#define PG8_LAS __attribute__((address_space(3)))
typedef unsigned short bf16_t;
typedef short bf16x8 __attribute__((ext_vector_type(8)));
typedef float f32x4 __attribute__((ext_vector_type(4)));
typedef unsigned u32x4 __attribute__((ext_vector_type(4)));
constexpr int BM = 256, BK = 64, HALF = 128, HTB = HALF * BK * 2  , STAGE_BYTES = 8 * HTB, NXCD = 8, WGM = 8;

__host__ __device__ __forceinline__ int lds_byte(int r, int c) { const int st = (r >> 4) * 2 + (c >> 5), rr = r & 15, cc = c & 31, ob = rr * 64 + cc * 2; return st * 1024 + (ob ^ (((ob >> 9) & 1) << 5)); }
__host__ __device__ __forceinline__ void stage_rc(int b, int& R, int& C) { const int st = b / 1024, sb = b % 1024, swz = sb ^ (((sb >> 9) & 1) << 5); R = (st >> 1) * 16 + swz / 64; C = (st & 1) * 32 + (swz % 64) / 2; }
__host__ __device__ __forceinline__ int perm32(int rho) { const int n = rho >> 4, i = rho & 15; return 8 * (i >> 2) + 4 * n + (i & 3); }

struct Unit { int pm, pn, rm, rn; };
struct Gemm { const bf16_t* A; const bf16_t* Bt; int M, N, K; };

struct StaticOrder {
    int nM, nN, nwg, G, c;
    __host__ __device__ void init(int M, int N, int G_, int c_) { nM = M / BM; nN = N / BM; nwg = nM * nN; G = G_; c = c_; }
    __host__ __device__ __forceinline__ bool next(int i, Unit& u) const {
        const long L = (long)i * G + c; if (L >= nwg) return false;
        int wgid = (int)L; { const int q = nwg / NXCD, r = nwg % NXCD, xcd = wgid % NXCD, off = wgid / NXCD; wgid = (xcd < r ? xcd * (q + 1) : r * (q + 1) + (xcd - r) * q) + off; }
        const int nig = WGM * nN, gid = wgid / nig, fm = gid * WGM, gsz = (nM - fm) < WGM ? (nM - fm) : WGM;
        u.pm = fm + ((wgid % nig) % gsz); u.pn = (wgid % nig) / gsz; return true;
    }
    __device__ __forceinline__ void a_ready(const Unit&) const {}
    __device__ __forceinline__ void done(const Unit&) const {}
};
typedef int i32x8 __attribute__((ext_vector_type(8)));
__device__ __forceinline__ i32x8 ld8(const PG8_LAS unsigned char* p) { typedef int i32x4 __attribute__((ext_vector_type(4))); const i32x4 a = *(const PG8_LAS i32x4*)p, b = *(const PG8_LAS i32x4*)(p + 1024); return __builtin_shufflevector(a, b, 0, 1, 2, 3, 4, 5, 6, 7); }
__device__ __forceinline__ i32x8 cat8(bf16x8 lo, bf16x8 hi) { typedef int i32x4 __attribute__((ext_vector_type(4))); const i32x4 a = __builtin_bit_cast(i32x4, lo), b = __builtin_bit_cast(i32x4, hi); return (i32x8){a[0], a[1], a[2], a[3], b[0], b[1], b[2], b[3]}; }
template <class Epi, class Sched, bool ALIGN_EPI = false, bool SP2 = false, bool HALFCAP = false, bool FP8 = false, bool MIDHOOK = false, bool GATHER = false>
__device__ __forceinline__ void gemm_phase(PG8_LAS unsigned char* lds, const Gemm g, const Sched& S, const Epi& E) {
    const int tid = threadIdx.x, wid = __builtin_amdgcn_readfirstlane(tid >> 6), lane = tid & 63, wr = wid >> 2, wc = wid & 3, fr = lane & 15, fq = lane >> 4;
    const int K = FP8 ? g.K / 2 : g.K, nt = K / BK;
    unsigned voffA[2], voffB[2];
#pragma unroll
    for (int i = 0; i < 2; ++i) { int R, C; stage_rc(tid * 16 + i * 8192, R, C); const int Rb = Epi::PERM ? ((R & ~31) + perm32(R & 31)) : R;
        voffA[i] = (unsigned)(R * K + C) * 2u; voffB[i] = (unsigned)(Rb * K + C) * 2u; }
    const size_t kstep = (size_t)(BK * 2);
    const size_t hstep = (size_t)HALF * K * 2;
    const size_t tstep = 2 * hstep;
    const unsigned ldsw = (unsigned)wid * 1024u;
    const int aoff = lds_byte(wr * 64 + fr, fq * 8), boff = lds_byte(wc * 32 + fr, fq * 8);
#define PG8_SA(b, h) (((b) * 2 + (h)) * HTB)
#define PG8_SB(b, h) ((4 + (b) * 2 + (h)) * HTB)
#define PG8_STAGE(bufoff, gbase, voff) do { _Pragma("unroll") for (int _i = 0; _i < 2; ++_i) \
        __builtin_amdgcn_global_load_lds((const unsigned*)((const char*)(gbase) + (voff)[_i]), (PG8_LAS unsigned*)(lds + (bufoff) + ldsw + _i * 8192), 16, 0, 0); } while (0)
#define PG8_LDA(dst, b, h) do { if constexpr (FP8) { _Pragma("unroll") for (int m = 0; m < 4; ++m) dst##8[m] = ld8(lds + PG8_SA(b, h) + aoff + m * 2048); } else { _Pragma("unroll") for (int m = 0; m < 4; ++m) _Pragma("unroll") for (int k = 0; k < 2; ++k) dst[m][k] = *(const PG8_LAS bf16x8*)(lds + PG8_SA(b, h) + aoff + m * 2048 + k * 1024); } } while (0)
#define PG8_LDB(dst, b, h) do { if constexpr (FP8) { _Pragma("unroll") for (int n = 0; n < 2; ++n) dst##8[n] = ld8(lds + PG8_SB(b, h) + boff + n * 2048); } else { _Pragma("unroll") for (int n = 0; n < 2; ++n) _Pragma("unroll") for (int k = 0; k < 2; ++k) dst[n][k] = *(const PG8_LAS bf16x8*)(lds + PG8_SB(b, h) + boff + n * 2048 + k * 1024); } } while (0)
#define PG8_MMA(ai, bj, At, Bt) do { __builtin_amdgcn_s_setprio(1); _Pragma("unroll") for (int m = 0; m < 4; ++m) _Pragma("unroll") for (int n = 0; n < 2; ++n) { \
        if constexpr (FP8) { asm volatile("v_mfma_scale_f32_16x16x128_f8f6f4 %0, %1, %2, %0, %3, %3 op_sel_hi:[0,0,0]" : "+v"(acc[ai][bj][m][n]) : "v"(Bt##8[n]), "v"(At##8[m]), "v"(sc_one)); } \
        else { _Pragma("unroll") for (int k = 0; k < 2; ++k) acc[ai][bj][m][n] = __builtin_amdgcn_mfma_f32_16x16x32_bf16(Bt[n][k], At[m][k], acc[ai][bj][m][n], 0, 0, 0); } } __builtin_amdgcn_s_setprio(0); } while (0)
#define PG8_WAIT_V(n) asm volatile("s_waitcnt vmcnt(" #n ")" ::: "memory")
#define PG8_WAIT_L(n) asm volatile("s_waitcnt lgkmcnt(" #n ")" ::: "memory")
#define PG8_BAR __builtin_amdgcn_s_barrier()
#define PG8_SCHED __builtin_amdgcn_sched_barrier(0)
    Unit cur, nxt; int ui = 0;
    if (!S.next(0, cur)) return;
    f32x4 acc[2][2][4][2];
#pragma unroll
    for (int a = 0; a < 2; ++a)
#pragma unroll
        for (int b = 0; b < 2; ++b)
#pragma unroll
            for (int m = 0; m < 4; ++m)
#pragma unroll
                for (int n = 0; n < 2; ++n) acc[a][b][m][n] = (f32x4){0.f, 0.f, 0.f, 0.f};
    bf16x8 At[4][2], B0[2][2], B1[2][2];
    i32x8 At8[4], B08[2], B18[2]; const int sc_one = 0x7f7f7f7f;
    const char* cA = (const char*)g.A + (size_t)cur.pm * tstep; const char* cB = (const char*)g.Bt + (size_t)cur.pn * tstep;
    S.a_ready(cur);
    unsigned cof[2][2] = {{0u, 0u}, {0u, 0u}}, nof[2][2] = {{0u, 0u}, {0u, 0u}}; int gR[2] = {0, 0}; unsigned gC[2] = {0u, 0u};
    if constexpr (GATHER) {
#pragma unroll
        for (int i = 0; i < 2; ++i) { int R, C; stage_rc(tid * 16 + i * 8192, R, C); gR[i] = R; gC[i] = (unsigned)C * 2u; }
#pragma unroll
        for (int h = 0; h < 2; ++h)
#pragma unroll
            for (int i = 0; i < 2; ++i) cof[h][i] = (unsigned)S.row_of(0, h * HALF + gR[i]) * (unsigned)(2 * K) + gC[i];
    }
#define PG8_STAGE_GA(bufoff, h, use_next, kb) do { const unsigned _o0 = (use_next) ? nof[h][0] : cof[h][0], _o1 = (use_next) ? nof[h][1] : cof[h][1]; const char* _gb = (const char*)g.A + (kb); \
        __builtin_amdgcn_global_load_lds((const unsigned*)(_gb + _o0), (PG8_LAS unsigned*)(lds + (bufoff) + ldsw), 16, 0, 0); \
        __builtin_amdgcn_global_load_lds((const unsigned*)(_gb + _o1), (PG8_LAS unsigned*)(lds + (bufoff) + ldsw + 8192), 16, 0, 0); } while (0)
    if constexpr (SP2) {
        PG8_STAGE(PG8_SB(0, 0), cB, voffB); PG8_STAGE(PG8_SB(0, 1), cB + hstep, voffB);
        if constexpr (GATHER) { PG8_STAGE_GA(PG8_SA(0, 0), 0, false, 0); PG8_STAGE_GA(PG8_SA(0, 1), 1, false, 0); } else { PG8_STAGE(PG8_SA(0, 0), cA, voffA); PG8_STAGE(PG8_SA(0, 1), cA + hstep, voffA); }
        if (wr == 1) PG8_BAR;
        PG8_WAIT_V(2); PG8_BAR;
        PG8_STAGE(PG8_SB(1, 0), cB + kstep, voffB); if constexpr (GATHER) PG8_STAGE_GA(PG8_SA(1, 0), 0, false, kstep); else PG8_STAGE(PG8_SA(1, 0), cA + kstep, voffA); PG8_STAGE(PG8_SB(1, 1), cB + hstep + kstep, voffB);
        PG8_WAIT_V(6); PG8_BAR;
    } else {
        PG8_STAGE(PG8_SB(0, 0), cB, voffB); PG8_STAGE(PG8_SA(0, 0), cA, voffA); PG8_STAGE(PG8_SB(0, 1), cB + hstep, voffB); PG8_STAGE(PG8_SA(0, 1), cA + hstep, voffA);
        if (wr == 1) PG8_BAR;
        PG8_WAIT_V(4); PG8_BAR;
        PG8_STAGE(PG8_SB(1, 0), cB + kstep, voffB); PG8_STAGE(PG8_SA(1, 0), cA + kstep, voffA); PG8_STAGE(PG8_SB(1, 1), cB + hstep + kstep, voffB);
        PG8_WAIT_V(6); PG8_BAR;
    }
    for (;;) {
        const bool has_next = S.next(ui + 1, nxt);
        const char* nA = has_next ? (const char*)g.A + (size_t)nxt.pm * tstep : cA; const char* nB = has_next ? (const char*)g.Bt + (size_t)nxt.pn * tstep : cB;
        const bool half = HALFCAP && cur.rm != 0;
        if constexpr (GATHER) {
#pragma unroll
            for (int h = 0; h < 2; ++h)
#pragma unroll
                for (int i = 0; i < 2; ++i) nof[h][i] = has_next ? (unsigned)S.row_of(ui + 1, h * HALF + gR[i]) * (unsigned)(2 * K) + gC[i] : cof[h][i];
        }
        for (int t = 0; t < nt; t += 2) {
            const bool last = (t == nt - 2);
            const char* a1 = cA + (size_t)(t + 1) * kstep;
            const char* a2 = last ? nA : cA + (size_t)(t + 2) * kstep; const char* b2 = last ? nB : cB + (size_t)(t + 2) * kstep;
            const char* a3 = a2 + kstep; const char* b3 = b2 + kstep;
            if constexpr (MIDHOOK) { if (t == nt / 2) E.mid(acc, cur, wr, wc, fr, fq); }
            if (last && has_next) S.a_ready(nxt);
            if constexpr (SP2) {
            PG8_LDB(B0, 0, 0); PG8_LDB(B1, 0, 1); PG8_SCHED; PG8_LDA(At, 0, 0); if constexpr (GATHER) PG8_STAGE_GA(PG8_SA(1, 1), 1, false, (size_t)(t + 1) * kstep); else PG8_STAGE(PG8_SA(1, 1), a1 + hstep, voffA);
            PG8_WAIT_V(8); PG8_WAIT_L(0); PG8_BAR; PG8_MMA(0, 0, At, B0); PG8_MMA(0, 1, At, B1); PG8_BAR; PG8_SCHED;
            if (!half) PG8_LDA(At, 0, 1); PG8_STAGE(PG8_SB(0, 0), b2, voffB); PG8_STAGE(PG8_SB(0, 1), b2 + hstep, voffB); if constexpr (GATHER) PG8_STAGE_GA(PG8_SA(0, 0), 0, last, last ? (size_t)0 : (size_t)(t + 2) * kstep); else PG8_STAGE(PG8_SA(0, 0), a2, voffA);
            PG8_WAIT_V(8); PG8_WAIT_L(0); PG8_BAR; if (!half) { PG8_MMA(1, 0, At, B0); PG8_MMA(1, 1, At, B1); } PG8_BAR; PG8_SCHED;
            PG8_LDB(B0, 1, 0); PG8_LDB(B1, 1, 1); PG8_SCHED; PG8_LDA(At, 1, 0); if constexpr (GATHER) PG8_STAGE_GA(PG8_SA(0, 1), 1, last, last ? (size_t)0 : (size_t)(t + 2) * kstep); else PG8_STAGE(PG8_SA(0, 1), a2 + hstep, voffA);
            PG8_WAIT_V(8); PG8_WAIT_L(0); PG8_BAR; PG8_MMA(0, 0, At, B0); PG8_MMA(0, 1, At, B1); PG8_BAR; PG8_SCHED;
            if (!half) PG8_LDA(At, 1, 1); PG8_STAGE(PG8_SB(1, 0), b3, voffB); PG8_STAGE(PG8_SB(1, 1), b3 + hstep, voffB); if constexpr (GATHER) PG8_STAGE_GA(PG8_SA(1, 0), 0, last, last ? kstep : (size_t)(t + 3) * kstep); else PG8_STAGE(PG8_SA(1, 0), a3, voffA);
            PG8_WAIT_V(8); PG8_WAIT_L(0); PG8_BAR; if (!half) { PG8_MMA(1, 0, At, B0); PG8_MMA(1, 1, At, B1); } PG8_BAR; PG8_SCHED;
            } else {
            PG8_LDB(B0, 0, 0); PG8_SCHED; PG8_LDA(At, 0, 0); PG8_STAGE(PG8_SA(1, 1), a1 + hstep, voffA);
            PG8_WAIT_L(8); PG8_BAR; PG8_WAIT_L(0); PG8_MMA(0, 0, At, B0); PG8_BAR; PG8_SCHED;
            PG8_LDB(B1, 0, 1); PG8_STAGE(PG8_SB(0, 0), b2, voffB);
            PG8_BAR; PG8_WAIT_L(0); PG8_MMA(0, 1, At, B1); PG8_BAR;
            PG8_LDA(At, 0, 1); PG8_STAGE(PG8_SA(0, 0), a2, voffA);
            PG8_BAR; PG8_WAIT_L(0); PG8_MMA(1, 0, At, B0); PG8_BAR; PG8_SCHED;
            PG8_STAGE(PG8_SB(0, 1), b2 + hstep, voffB);
            PG8_WAIT_V(6); PG8_BAR; PG8_MMA(1, 1, At, B1); PG8_BAR;
            PG8_LDB(B0, 1, 0); PG8_SCHED; PG8_LDA(At, 1, 0); PG8_STAGE(PG8_SA(0, 1), a2 + hstep, voffA);
            PG8_WAIT_L(8); PG8_BAR; PG8_WAIT_L(0); PG8_MMA(0, 0, At, B0); PG8_BAR; PG8_SCHED;
            PG8_LDB(B1, 1, 1); PG8_STAGE(PG8_SB(1, 0), b3, voffB);
            PG8_BAR; PG8_WAIT_L(0); PG8_MMA(0, 1, At, B1); PG8_BAR;
            PG8_LDA(At, 1, 1); PG8_STAGE(PG8_SA(1, 0), a3, voffA);
            PG8_BAR; PG8_WAIT_L(0); PG8_MMA(1, 0, At, B0); PG8_BAR; PG8_SCHED;
            PG8_STAGE(PG8_SB(1, 1), b3 + hstep, voffB);
            PG8_WAIT_V(6); PG8_BAR; PG8_MMA(1, 1, At, B1); PG8_BAR;
            }
        }
        if constexpr (FP8) asm volatile("s_nop 15\n\ts_nop 15" ::: "memory");
        if constexpr (ALIGN_EPI) { if (wr == 0) PG8_BAR; }
        if constexpr (!Epi::AFTER_DRAIN) { E(acc, cur, wr, wc, fr, fq); S.done(cur); }
        if (!has_next) break;
#pragma unroll
        for (int a = 0; a < 2; ++a)
#pragma unroll
            for (int b = 0; b < 2; ++b)
#pragma unroll
                for (int m = 0; m < 4; ++m)
#pragma unroll
                    for (int n = 0; n < 2; ++n) acc[a][b][m][n] = (f32x4){0.f, 0.f, 0.f, 0.f};
        cur = nxt; cA = nA; cB = nB; ++ui;
        if constexpr (GATHER) { cof[0][0] = nof[0][0]; cof[0][1] = nof[0][1]; cof[1][0] = nof[1][0]; cof[1][1] = nof[1][1]; }
        if constexpr (ALIGN_EPI) { if (wr == 1) PG8_BAR; }
    }
    PG8_WAIT_V(0);
    if constexpr (!ALIGN_EPI) { if (wr == 0) PG8_BAR; }
    PG8_BAR;
    if constexpr (Epi::AFTER_DRAIN) { E.fused(acc, cur, wr, wc, fr, fq, lds, wid, lane); S.done(cur); }
#undef PG8_SA
#undef PG8_SB
#undef PG8_STAGE
#undef PG8_STAGE_GA
#undef PG8_LDA
#undef PG8_LDB
#undef PG8_MMA
#undef PG8_WAIT_V
#undef PG8_WAIT_L
#undef PG8_BAR
#undef PG8_SCHED
}
}

constexpr int NB = 2, SEQ = 4096, T = NB * SEQ, D = 2048, NIN = 8448;
constexpr int C_QA = 0, C_KA = 1024, C_VA = 1152, C_QB = 1280, C_KB = 2304, C_VB = 3328, C_GA = 4352, C_GB = 6400;
constexpr int NE = 32, FF = 2048, MEMLEN = 256;
constexpr int RMAX = 32768 + NE * 256;
constexpr float ALPHA = 1.18920711500272f;
constexpr float LN_EPS = 1e-5f;
constexpr int NWAVES = 8;
#ifndef MK_ONE_LAUNCH
#define MK_ONE_LAUNCH 1
#endif
constexpr int NPHASE = 14;

constexpr size_t MiB = 1u << 20;
constexpr size_t WS_CTL = 0, CTL_ZERO_BYTES = 65536;
constexpr size_t WS_TAB = 1 * MiB;
constexpr size_t WS_ROUTE = 2 * MiB;
constexpr size_t WS_BT1 = 4 * MiB;
constexpr size_t WS_BTAB = 54 * MiB;
constexpr size_t WS_BTMIX = 62 * MiB, WS_BTXQ = 70 * MiB, WS_BTXO = 78 * MiB;
constexpr size_t WS_BTUP = 88 * MiB;
constexpr size_t WS_BTDN = 600 * MiB;
constexpr size_t WS_H0F = 856 * MiB;
constexpr size_t WS_H0B = 920 * MiB;
constexpr size_t WS_PROJ = 954 * MiB;
constexpr size_t WS_KMEM = 1086 * MiB;
constexpr size_t WS_VT = 1088 * MiB;
constexpr size_t WS_OAB = 1090 * MiB;
constexpr size_t WS_G1 = 1122 * MiB;
constexpr size_t WS_GG = 1186 * MiB;
constexpr size_t WS_S1 = 1218 * MiB;
constexpr size_t WS_H1F = 1282 * MiB, WS_H1B = 1346 * MiB, WS_QX = 1378 * MiB, WS_OX = 1410 * MiB, WS_H2F = 1442 * MiB, WS_H2B = 1506 * MiB;
constexpr size_t WS_XS = 1538 * MiB, WS_ACT = 1698 * MiB, WS_YR = 1858 * MiB, WS_END = 2018 * MiB;
static_assert(WS_BT1 + (size_t)12544 * 2048 * 2 <= WS_BTAB && WS_H0B + (size_t)8704 * 2048 * 2 <= WS_PROJ && WS_PROJ + (size_t)T * NIN * 2 <= WS_KMEM && WS_XS + (size_t)RMAX * 2048 * 2 <= WS_ACT, "ws map");

constexpr int CW_TMO = 0, CW_CODE = 1;
constexpr int CW_CNT = 1024;
constexpr int CW_SUB = 3584;
constexpr int CW_BAR = 4096;

constexpr int RING_OFF = 0, RING_BYTES = 131072;
constexpr int LDSCTL_OFF = RING_BYTES, MISC_OFF = LDSCTL_OFF + 320;
constexpr int LDS_BYTES = 147456;

#define GAS __attribute__((address_space(1)))
#define LAS __attribute__((address_space(3)))
typedef unsigned short bf16;
typedef unsigned v4u __attribute__((ext_vector_type(4)));
typedef unsigned v2u __attribute__((ext_vector_type(2)));
typedef float f32x4 __attribute__((ext_vector_type(4)));
typedef GAS unsigned gu32;
#define RLX_AGENT __ATOMIC_RELAXED, __HIP_MEMORY_SCOPE_AGENT
#define LDS_WAIT() asm volatile("s_waitcnt lgkmcnt(0)" ::: "memory")
#define VM_WAIT() asm volatile("s_waitcnt vmcnt(0)" ::: "memory")
typedef float f32x2_ __attribute__((ext_vector_type(2)));
typedef __bf16 bf16x2_ __attribute__((ext_vector_type(2)));
__device__ __forceinline__ unsigned pk2(float lo, float hi) { const f32x2_ v = {lo, hi}; const bf16x2_ b = __builtin_convertvector(v, bf16x2_); return __builtin_bit_cast(unsigned, b); }
__device__ __forceinline__ float bflo(unsigned w) { return __uint_as_float(w << 16); }
__device__ __forceinline__ float bfhi(unsigned w) { return __uint_as_float(w & 0xffff0000u); }
__device__ __forceinline__ float sigmoidf_(float x) { return __builtin_amdgcn_rcpf(1.0f + __expf(-x)); }
__device__ __forceinline__ float wave_sum(float v) {
#pragma unroll
    for (int o = 1; o < 64; o <<= 1) v += __shfl_xor(v, o);
    return v;
}
__device__ __forceinline__ unsigned pk4_fp8(float a, float b, float c, float d) { int w = __builtin_amdgcn_cvt_pk_fp8_f32(a, b, 0, false); w = __builtin_amdgcn_cvt_pk_fp8_f32(c, d, w, true); return (unsigned)w; }
constexpr float W8_SCALE = 64.0f, W8_INV = 1.0f / 64.0f;
#define XB_TMO      128
#define XB_XCNT(j)  (256  + 64 * (j))
#define XB_XSUB(j)  (1280 + 64 * (j))
#define XB_XGEN(j)  (2304 + 64 * (j))
#define XB_TOP      3328
#define XB_TOPGEN   3392
#define XCD_BAR_WORDS 3456
#define XB_SPIN_CAP (1u << 18)

__device__ __forceinline__ unsigned xb_ld(unsigned* p)              { return __hip_atomic_load(p, __ATOMIC_RELAXED, __HIP_MEMORY_SCOPE_AGENT); }
__device__ __forceinline__ unsigned xb_add(unsigned* p, unsigned v) { return __hip_atomic_fetch_add(p, v, __ATOMIC_RELAXED, __HIP_MEMORY_SCOPE_AGENT); }
__device__ __forceinline__ unsigned xb_xcc_id() { return (unsigned)__builtin_amdgcn_s_getreg((3 << 11) | 20) & 0xFu; }
#define XB_SPIN(cond, bar) do { unsigned _sp = 0; while (cond) { __builtin_amdgcn_s_sleep(1); \
    if ((++_sp & 255u) == 0u) { if (xb_ld(&(bar)[XB_TMO])) break; if (_sp > XB_SPIN_CAP) { atomicAdd(&(bar)[XB_TMO], 1u); break; } } } } while (0)

struct XcdBarrier {
    unsigned* bar; unsigned x;
    volatile LAS unsigned* st;
};

__device__ __forceinline__ XcdBarrier xcd_barrier_post(unsigned* bar, volatile LAS unsigned* st) {
    XcdBarrier b; b.bar = bar; b.x = xb_xcc_id(); b.st = st;
    if (threadIdx.x == 0) (void)xb_add(&bar[XB_XCNT(b.x)], 1u);
    return b;
}
__device__ __forceinline__ void xcd_barrier_complete(unsigned* bar, unsigned x, unsigned& nloc, unsigned& nx) {
    const unsigned G = gridDim.x * gridDim.y * gridDim.z;
    unsigned sum, cnt, mine, sp = 0u;
    for (;;) {
        sum = 0u; cnt = 0u; mine = 0u;
#pragma unroll
        for (unsigned j = 0; j < 16; ++j) { const unsigned c = xb_ld(&bar[XB_XCNT(j)]); sum += c; cnt += (c > 0u) ? 1u : 0u; mine = (j == x) ? c : mine; }
        if (sum == G) break;
        __builtin_amdgcn_s_sleep(1);
        if ((++sp & 255u) == 0u) { if (xb_ld(&bar[XB_TMO])) break; if (sp > XB_SPIN_CAP) { atomicAdd(&bar[XB_TMO], 1u); break; } }
    }
    nloc = mine > 0u ? mine : 1u; nx = cnt > 0u ? cnt : 1u;
}

__device__ __forceinline__ void xcd_barrier(const XcdBarrier& b) {
    asm volatile("s_waitcnt vmcnt(0)" ::: "memory");
    __syncthreads();
    if (threadIdx.x == 0) {
        unsigned* bar = b.bar;
        __builtin_amdgcn_s_waitcnt(0);
        unsigned nloc = b.st[0], nx = b.st[1];
        if (nloc == 0u) { xcd_barrier_complete(bar, b.x, nloc, nx); b.st[0] = nloc; b.st[1] = nx; }
        const unsigned old = xb_add(&bar[XB_XSUB(b.x)], 1u);
        const unsigned gen = old / nloc;
        if (old + 1u == (gen + 1u) * nloc) {
            __builtin_amdgcn_fence(__ATOMIC_RELEASE, "agent");
            asm volatile("s_waitcnt vmcnt(0)" ::: "memory");
            const unsigned og = xb_add(&bar[XB_TOP], 1u);
            const unsigned tg = og / nx;
            if (og + 1u == (tg + 1u) * nx) xb_add(&bar[XB_TOPGEN], 1u);
            else XB_SPIN(xb_ld(&bar[XB_TOPGEN]) == tg, bar);
            __builtin_amdgcn_fence(__ATOMIC_ACQUIRE, "agent");
            xb_add(&bar[XB_XGEN(b.x)], 1u);
            asm volatile("s_waitcnt vmcnt(0)" ::: "memory");
        } else {
            XB_SPIN(xb_ld(&bar[XB_XGEN(b.x)]) == gen, bar);
            __builtin_amdgcn_fence(__ATOMIC_ACQUIRE, "agent");
            asm volatile("s_waitcnt vmcnt(0)" ::: "memory");
        }
    }
    __syncthreads();
}

namespace blk {
using pg8::Unit; using pg8::f32x4; using pg8::u32x4; using pg8::bf16_t;
typedef float f32x4_t __attribute__((ext_vector_type(4)));

struct SchedP1 {
    pg8::StaticOrder so;
    __device__ __forceinline__ void init(int G, int c) { so.init(T, NIN, G, c); }
    __device__ __forceinline__ bool next(int i, Unit& u) const {
        const long L = (long)i * so.G + so.c;
        constexpr int MA = (int)(WS_H0B / MiB), MB = (int)(WS_BT1 / MiB);
        if (L < so.nwg) { if (!so.next(i, u)) return false; u.rm = u.pm; u.rn = u.pn; u.pm += MA; u.pn += MB; return true; }
        const int j = (int)(L - so.nwg); if (j >= 32) return false;
        if (j < 16) { const int mb = j & 1, ct = j >> 1; u.pm = MA + 32 + mb; u.pn = MB + 33 + ct; u.rm = mb; u.rn = 64 + ct; }
        else { const int jj = j - 16, dt = jj >> 1, mb = jj & 1; u.pm = MB + 33 + 8 + dt; u.pn = MA + 32 + mb; u.rm = dt; u.rn = 128 + mb; }
        return true;
    }
    __device__ __forceinline__ void a_ready(const Unit&) const {}
    __device__ __forceinline__ void done(const Unit&) const {}
};
struct EpiProj {
    static constexpr bool PERM = true, AFTER_DRAIN = false;
    unsigned char* ws; const float* bias;
    __device__ __forceinline__ void operator()(const f32x4 (&acc)[2][2][4][2], const Unit& u, int wr, int wc, int fr, int fq) const {
        const int kind = u.rn >> 6; const bool mn = kind == 0;
        bf16_t* base = (bf16_t*)(ws + WS_PROJ + (size_t)(kind >= 1) * (WS_KMEM - WS_PROJ) + (size_t)(kind >= 2) * (WS_VT - WS_KMEM)); const int ldc = 512 + (kind <= 1) * 1536 + (kind == 0) * (NIN - 2048);
        const int row0 = u.rm * 256 + wr * 64 + fr, col0 = (u.rn & 63) * 256 + wc * 32 + 8 * fq;
        f32x4 bv[2][2];
#pragma unroll
        for (int bj = 0; bj < 2; ++bj)
#pragma unroll
            for (int n = 0; n < 2; ++n) bv[bj][n] = mn ? *(const f32x4*)(bias + col0 + bj * 128 + 4 * n) : (f32x4){0.f, 0.f, 0.f, 0.f};
#pragma unroll
        for (int ai = 0; ai < 2; ++ai)
#pragma unroll
            for (int m = 0; m < 4; ++m) { bf16_t* rowp = base + (size_t)(row0 + ai * 128 + m * 16) * ldc + col0;
#pragma unroll
                for (int bj = 0; bj < 2; ++bj) { const f32x4 v0 = acc[ai][bj][m][0] + bv[bj][0], v1 = acc[ai][bj][m][1] + bv[bj][1];
                    u32x4 w; w.x = pk2(v0[0], v0[1]); w.y = pk2(v0[2], v0[3]); w.z = pk2(v1[0], v1[1]); w.w = pk2(v1[2], v1[3]);
                    *(u32x4*)(rowp + bj * 128) = w; } }
    }
};
struct EpiBf16B {
    static constexpr bool PERM = true, AFTER_DRAIN = false;
    bf16_t* O; int ldc; const float* bias; int cmask, cshift, bstride; float scale;
    __device__ __forceinline__ void operator()(const f32x4 (&acc)[2][2][4][2], const Unit& u, int wr, int wc, int fr, int fq) const {
        const int row0 = u.pm * 256 + wr * 64 + fr, col0 = (u.pn & cmask) * 256 + wc * 32 + 8 * fq;
        const float* bp = bias ? bias + (size_t)(u.pn >> cshift) * bstride + col0 : nullptr;
        f32x4 bv[2][2];
#pragma unroll
        for (int bj = 0; bj < 2; ++bj)
#pragma unroll
            for (int n = 0; n < 2; ++n) bv[bj][n] = bp ? *(const f32x4*)(bp + bj * 128 + 4 * n) : (f32x4){0.f, 0.f, 0.f, 0.f};
#pragma unroll
        for (int ai = 0; ai < 2; ++ai)
#pragma unroll
            for (int m = 0; m < 4; ++m) { bf16_t* rowp = O + (size_t)(row0 + ai * 128 + m * 16) * ldc + col0;
#pragma unroll
                for (int bj = 0; bj < 2; ++bj) { const f32x4 v0 = acc[ai][bj][m][0] * scale + bv[bj][0], v1 = acc[ai][bj][m][1] * scale + bv[bj][1];
                    u32x4 w; w.x = pk2(v0[0], v0[1]); w.y = pk2(v0[2], v0[3]); w.z = pk2(v1[0], v1[1]); w.w = pk2(v1[2], v1[3]);
                    *(u32x4*)(rowp + bj * 128) = w; } }
    }
};
struct EpiGate {
    static constexpr bool PERM = true, AFTER_DRAIN = false;
    const bf16_t* proj; bf16_t* gg;
    __device__ __forceinline__ static float em(float x) { return __expf(-x); }
    __device__ __forceinline__ void mid(f32x4 (&acc)[2][2][4][2], const Unit& u, int wr, int wc, int fr, int fq) const {
        int row0 = u.pm * 256 + wr * 64 + fr; const int col0 = u.pn * 256 + wc * 32 + 8 * fq;
        asm volatile("" : "+v"(row0));
#pragma unroll
        for (int ai = 0; ai < 2; ++ai)
#pragma unroll
            for (int m = 0; m < 4; ++m) { const size_t row = (size_t)(row0 + ai * 128 + m * 16);
#pragma unroll
                for (int bj = 0; bj < 2; ++bj) {
                    const u32x4 ga = *(const u32x4*)(proj + row * NIN + C_GA + col0 + bj * 128), gb = *(const u32x4*)(proj + row * NIN + C_GB + col0 + bj * 128);
                    const unsigned gaw[4] = {ga.x, ga.y, ga.z, ga.w}, gbw[4] = {gb.x, gb.y, gb.z, gb.w};
#pragma unroll
                    for (int q = 0; q < 4; ++q) {
                        const float r0 = (1.0f + em(fmaxf(bflo(gbw[q]), -60.0f))) * __builtin_amdgcn_rcpf(1.0f + em(bflo(gaw[q]))), r1 = (1.0f + em(fmaxf(bfhi(gbw[q]), -60.0f))) * __builtin_amdgcn_rcpf(1.0f + em(bfhi(gaw[q])));
                        acc[ai][bj][m][q >> 1][2 * (q & 1)] *= r0; acc[ai][bj][m][q >> 1][2 * (q & 1) + 1] *= r1; } }
                asm volatile("" ::: "memory"); }
    }
    __device__ __forceinline__ void operator()(const f32x4 (&acc)[2][2][4][2], const Unit& u, int wr, int wc, int fr, int fq) const {
        int row0 = u.pm * 256 + wr * 64 + fr; const int col0 = u.pn * 256 + wc * 32 + 8 * fq;
        asm volatile("" : "+v"(row0));
#pragma unroll
        for (int ai = 0; ai < 2; ++ai)
#pragma unroll
            for (int m = 0; m < 4; ++m) { const size_t row = (size_t)(row0 + ai * 128 + m * 16);
#pragma unroll
                for (int bj = 0; bj < 2; ++bj) {
                    const u32x4 gb = *(const u32x4*)(proj + row * NIN + C_GB + col0 + bj * 128);
                    const unsigned gbw[4] = {gb.x, gb.y, gb.z, gb.w}; float o[8];
#pragma unroll
                    for (int q = 0; q < 4; ++q) { o[2 * q] = acc[ai][bj][m][q >> 1][2 * (q & 1)] * __builtin_amdgcn_rcpf(1.0f + em(fmaxf(bflo(gbw[q]), -60.0f))); o[2 * q + 1] = acc[ai][bj][m][q >> 1][2 * (q & 1) + 1] * __builtin_amdgcn_rcpf(1.0f + em(fmaxf(bfhi(gbw[q]), -60.0f))); }
                    u32x4 w; w.x = pk2(o[0], o[1]); w.y = pk2(o[2], o[3]); w.z = pk2(o[4], o[5]); w.w = pk2(o[6], o[7]);
                    *(u32x4*)(gg + row * D + col0 + bj * 128) = w; } }
    }
};
struct EpiRes {
    static constexpr bool PERM = false, AFTER_DRAIN = false;
    const float* res; float* out;
    __device__ __forceinline__ void operator()(const f32x4 (&acc)[2][2][4][2], const Unit& u, int wr, int wc, int fr, int fq) const {
        const int row0 = u.pm * 256 + wr * 64 + fr, col0 = u.pn * 256 + wc * 32 + 4 * fq;
#pragma unroll
        for (int ai = 0; ai < 2; ++ai)
#pragma unroll
            for (int m = 0; m < 4; ++m) { const size_t off = (size_t)(row0 + ai * 128 + m * 16) * D + col0;
#pragma unroll
                for (int bj = 0; bj < 2; ++bj)
#pragma unroll
                    for (int n = 0; n < 2; ++n) { const f32x4 r = *(const f32x4*)(res + off + bj * 128 + n * 16);
                        *(f32x4*)(out + off + bj * 128 + n * 16) = r * ALPHA + acc[ai][bj][m][n]; } }
    }
};
struct SchedMoE {
    static constexpr int RT_LDS = 12;
    const PG8_LAS int* mine; const PG8_LAS int* rts; const int* rowtok; int n;
    __device__ __forceinline__ void init(const int* tab, int nN, int G, int c, PG8_LAS int* lds_list, int tid, const int* rowtok_ = nullptr) {
        const int nwg = tab[192] * nN; const int* ul = tab + (nN == 16 ? 1024 : 8192);
        n = c < nwg ? (nwg - c + G - 1) / G : 0;
        if (tid < n && tid < 256) lds_list[tid] = ul[tid * G + c];
        rowtok = rowtok_; PG8_LAS int* r = lds_list + 256;
        if (rowtok_) { for (int i = 0; i < n && i < RT_LDS; ++i) { const int pm = ul[i * G + c] & 0xffff; if (tid < 256) r[i * 256 + tid] = rowtok_[pm * 256 + tid]; } }
        __syncthreads();
        mine = lds_list; rts = r;
    }
    __device__ __forceinline__ bool next(int i, Unit& u) const {
        if (i >= n) return false;
        const int x = mine[i]; u.pm = x & 0xffff; u.pn = x >> 16; u.rm = 0; u.rn = 0; return true;
    }
    __device__ __forceinline__ int row_of(int i, int r) const { return i < RT_LDS ? rts[i * 256 + r] : rowtok[(mine[i] & 0xffff) * 256 + r]; }
    __device__ __forceinline__ void a_ready(const Unit&) const {}
    __device__ __forceinline__ void done(const Unit&) const {}
};
struct EpiSwiGLU {
    static constexpr bool PERM = true, AFTER_DRAIN = false;
    unsigned char* act; const float* b_up;
    __device__ __forceinline__ void operator()(const f32x4 (&acc)[2][2][4][2], const Unit& u, int wr, int wc, int fr, int fq) const {
        const int e = u.pn >> 4, ct = u.pn & 15;
        const int row0 = u.pm * 256 + wr * 64 + fr, c8 = ct * 128 + wc * 32 + 8 * fq;
        f32x4 bg[2], bl[2];
#pragma unroll
        for (int n = 0; n < 2; ++n) { bg[n] = *(const f32x4*)(b_up + (size_t)e * 4096 + c8 + 4 * n); bl[n] = *(const f32x4*)(b_up + (size_t)e * 4096 + 2048 + c8 + 4 * n); }
#pragma unroll
        for (int ai = 0; ai < 2; ++ai)
#pragma unroll
            for (int m = 0; m < 4; ++m) { unsigned char* rowp = act + (size_t)(row0 + ai * 128 + m * 16) * FF + c8;
                float a[8];
#pragma unroll
                for (int n = 0; n < 2; ++n) { const f32x4 g = acc[ai][0][m][n] * W8_INV + bg[n], l = acc[ai][1][m][n] * W8_INV + bl[n];
#pragma unroll
                    for (int j = 0; j < 4; ++j) { const float gl = fminf(g[j], 7.0f), li = fminf(fmaxf(l[j], -7.0f), 7.0f);
                        a[4 * n + j] = gl * sigmoidf_(1.702f * gl) * (li + 1.0f); } }
                v2u w; w.x = pk4_fp8(a[0], a[1], a[2], a[3]); w.y = pk4_fp8(a[4], a[5], a[6], a[7]);
                *(v2u*)rowp = w; }
    }
};
}

struct Frame {
    LAS unsigned char* lds;
    volatile LAS unsigned* MISC;
    gu32* ctl;
    int tid, lane, wave, vcu, G;
    const float* const* in; float* out; unsigned char* ws;
};
#define WSP(type, off) ((type*)(F.ws + (off)))

#ifndef CVT_HASH
#define CVT_HASH 0
#endif
struct CvtMat { const float* W; void* WT; int K, N, drow_base, upperm, total, pitch, koff; };
constexpr int CVT_LP16 = 4;
constexpr int CVT_LP8 = 3;
template <bool FP8> __device__ __forceinline__ void cvt_addr(const CvtMat& M, int it_, const float*& src, unsigned char*& dst) {
    int it = it_;
    constexpr int LP = FP8 ? CVT_LP8 : CVT_LP16, KTS = 10 - LP, NTS = 2 + LP;
    if (FP8 && CVT_HASH) it = (int)(((unsigned)it * 40503u) & (unsigned)(M.total - 1));
    const int nblk = M.N >> NTS, per_e = (M.K >> KTS) * nblk, e = it / per_e, r = it - e * per_e, kb = r / nblk, nb = r - kb * nblk, n0 = nb << NTS;
    int drow = M.drow_base + n0;
    if (M.upperm) { const int half = n0 >= 2048 ? 1 : 0, nn = n0 - half * 2048; drow = (nn >> 7) * 256 + half * 128 + (nn & 127); }
    src = M.W + ((size_t)e * M.K + (kb << KTS)) * M.N + n0;
    dst = (unsigned char*)M.WT + (((size_t)e * M.N + drow) * M.pitch + M.koff + (kb << KTS)) * (FP8 ? 1 : 2);
}
__device__ __forceinline__ void tr_load(f32x4 (&v)[16], const float* src, int N, unsigned loff) {
    const unsigned long long base = (unsigned long long)src;
    const unsigned blo = __builtin_amdgcn_readfirstlane((unsigned)base), bhi = __builtin_amdgcn_readfirstlane((unsigned)(base >> 32));
    const unsigned long long ub = ((unsigned long long)bhi << 32) | blo; const unsigned long long rstep = (unsigned long long)(unsigned)N * 4ull;
#pragma unroll
    for (int i = 0; i < 16; ++i) { const unsigned long long rb = ub + (unsigned long long)i * rstep;
        asm volatile("global_load_dwordx4 %0, %1, %2 nt" : "=&v"(v[i]) : "v"(loff), "s"(rb) : "memory"); }
}
template <int NYOUNG> __device__ __forceinline__ void tr_wait(f32x4 (&v)[16]) {
    asm volatile("s_waitcnt vmcnt(%16)" : "+v"(v[0]), "+v"(v[1]), "+v"(v[2]), "+v"(v[3]), "+v"(v[4]), "+v"(v[5]), "+v"(v[6]), "+v"(v[7]), "+v"(v[8]), "+v"(v[9]), "+v"(v[10]), "+v"(v[11]), "+v"(v[12]), "+v"(v[13]), "+v"(v[14]), "+v"(v[15]) : "n"(NYOUNG) : "memory");
}
__device__ __forceinline__ void tr_store(const f32x4 (&v)[16], unsigned char* dst8, int K, int lane) {
    bf16* d0 = (bf16*)dst8 + (size_t)(4 * (lane & ((1 << CVT_LP16) - 1))) * K + 16 * (lane >> CVT_LP16);
#pragma unroll
    for (int j = 0; j < 4; ++j) {
        v4u lo, hi;
        lo.x = pk2(v[0][j], v[1][j]); lo.y = pk2(v[2][j], v[3][j]); lo.z = pk2(v[4][j], v[5][j]); lo.w = pk2(v[6][j], v[7][j]);
        hi.x = pk2(v[8][j], v[9][j]); hi.y = pk2(v[10][j], v[11][j]); hi.z = pk2(v[12][j], v[13][j]); hi.w = pk2(v[14][j], v[15][j]);
        bf16* d = d0 + (size_t)j * K;
        *(v4u*)d = lo; *(v4u*)(d + 8) = hi;
    }
}
__device__ __forceinline__ void tr_store_fp8(const f32x4 (&v)[16], unsigned char* dst8, int K, int lane) {
    unsigned char* d0 = dst8 + (size_t)(4 * (lane & ((1 << CVT_LP8) - 1))) * K + 16 * (lane >> CVT_LP8);
#pragma unroll
    for (int j = 0; j < 4; ++j) {
        v4u o;
        o.x = pk4_fp8(v[0][j] * W8_SCALE, v[1][j] * W8_SCALE, v[2][j] * W8_SCALE, v[3][j] * W8_SCALE); o.y = pk4_fp8(v[4][j] * W8_SCALE, v[5][j] * W8_SCALE, v[6][j] * W8_SCALE, v[7][j] * W8_SCALE);
        o.z = pk4_fp8(v[8][j] * W8_SCALE, v[9][j] * W8_SCALE, v[10][j] * W8_SCALE, v[11][j] * W8_SCALE); o.w = pk4_fp8(v[12][j] * W8_SCALE, v[13][j] * W8_SCALE, v[14][j] * W8_SCALE, v[15][j] * W8_SCALE);
        *(v4u*)(d0 + (size_t)j * K) = o;
    }
}
template <bool FP8> __device__ __forceinline__ void convert_mat(const CvtMat& M, int total, int wi, int nw, int lane) {
    constexpr int LP = FP8 ? CVT_LP8 : CVT_LP16;
    const unsigned loff = (unsigned)((16 * (lane >> LP)) * M.N + 4 * (lane & ((1 << LP) - 1))) * 4u;
    int it = wi;
    if constexpr (FP8) {
        for (; it + nw < total; it += 2 * nw) {
            const float* s0; const float* s1; unsigned char* d0; unsigned char* d1;
            cvt_addr<FP8>(M, it, s0, d0); cvt_addr<FP8>(M, it + nw, s1, d1);
            f32x4 v0[16], v1[16];
            tr_load(v0, s0, M.N, loff); tr_load(v1, s1, M.N, loff);
            tr_wait<16>(v0); tr_store_fp8(v0, d0, M.pitch, lane);
            tr_wait<0>(v1); tr_store_fp8(v1, d1, M.pitch, lane);
        }
    }
    if constexpr (!FP8)
    for (; it + 2 * nw < total; it += 3 * nw) {
        const float* s0; const float* s1; const float* s2; unsigned char* d0; unsigned char* d1; unsigned char* d2;
        cvt_addr<FP8>(M, it, s0, d0); cvt_addr<FP8>(M, it + nw, s1, d1); cvt_addr<FP8>(M, it + 2 * nw, s2, d2);
        f32x4 v0[16], v1[16], v2[16];
        tr_load(v0, s0, M.N, loff); tr_load(v1, s1, M.N, loff); tr_load(v2, s2, M.N, loff);
        tr_wait<32>(v0); if (FP8) tr_store_fp8(v0, d0, M.pitch, lane); else tr_store(v0, d0, M.pitch, lane);
        tr_wait<16>(v1); if (FP8) tr_store_fp8(v1, d1, M.pitch, lane); else tr_store(v1, d1, M.pitch, lane);
        tr_wait<0>(v2); if (FP8) tr_store_fp8(v2, d2, M.pitch, lane); else tr_store(v2, d2, M.pitch, lane);
    }
    for (; it < total; it += nw) {
        const float* s0; unsigned char* d0; cvt_addr<FP8>(M, it, s0, d0);
        f32x4 v0[16]; tr_load(v0, s0, M.N, loff); tr_wait<0>(v0); if (FP8) tr_store_fp8(v0, d0, M.pitch, lane); else tr_store(v0, d0, M.pitch, lane);
    }
}
__device__ __forceinline__ void ln_row(f32x4 (&v)[8], const float* g, const float* b, int lane) {
    float s = 0.f;
#pragma unroll
    for (int j = 0; j < 8; ++j) s += (v[j][0] + v[j][1]) + (v[j][2] + v[j][3]);
    const float mean = wave_sum(s) * (1.f / D);
    float s2 = 0.f;
#pragma unroll
    for (int j = 0; j < 8; ++j) { v[j] = v[j] - mean; s2 += (v[j][0] * v[j][0] + v[j][1] * v[j][1]) + (v[j][2] * v[j][2] + v[j][3] * v[j][3]); }
    const float rstd = 1.0f / sqrtf(wave_sum(s2) * (1.f / D) + LN_EPS);
#pragma unroll
    for (int j = 0; j < 8; ++j) { const f32x4 gg = ((const f32x4*)g)[lane + 64 * j], bb = ((const f32x4*)b)[lane + 64 * j]; v[j] = v[j] * rstd * gg + bb; }
}
__device__ __forceinline__ void row_load(f32x4 (&v)[8], const float* p, int lane) {
#pragma unroll
    for (int j = 0; j < 8; ++j) v[j] = ((const f32x4*)p)[lane + 64 * j];
}
__device__ __forceinline__ void row_store_f32(const f32x4 (&v)[8], float* p, int lane) {
#pragma unroll
    for (int j = 0; j < 8; ++j) ((f32x4*)p)[lane + 64 * j] = v[j];
}
__device__ __forceinline__ void row_store_bf16(const f32x4 (&v)[8], bf16* p, int lane) {
#pragma unroll
    for (int j = 0; j < 8; ++j) { v2u w; w.x = pk2(v[j][0], v[j][1]); w.y = pk2(v[j][2], v[j][3]); ((v2u*)p)[lane + 64 * j] = w; }
}

__device__ __forceinline__ void p0_prologue(Frame& F) {
    const int gw = F.vcu * NWAVES + F.wave, NGW = F.G * NWAVES;
    { const CvtMat M{F.in[5], WSP(bf16, WS_BT1), 2048, NIN, 0, 0, 32 * 132, 2048, 0}; convert_mat<false>(M, 32 * 132, gw, NGW, F.lane); }
    { const CvtMat M{F.in[14], WSP(bf16, WS_BT1), 2048, 4096, NIN, 0, 32 * 64, 2048, 0}; convert_mat<false>(M, 32 * 64, gw, NGW, F.lane); }
    for (int m = gw; m < T; m += NGW) {
        f32x4 v[8]; row_load(v, F.in[0] + (size_t)m * D, F.lane);
        ln_row(v, F.in[2], F.in[3], F.lane);
        row_store_f32(v, WSP(float, WS_H0F) + (size_t)m * D, F.lane);
        row_store_bf16(v, WSP(bf16, WS_H0B) + (size_t)m * D, F.lane);
    }
    for (int m = gw; m < NB * MEMLEN; m += NGW) {
        f32x4 v[8]; row_load(v, F.in[1] + (size_t)m * D, F.lane);
        row_store_bf16(v, WSP(bf16, WS_H0B) + (size_t)(T + m) * D, F.lane);
    }
}

__device__ __forceinline__ void cvt_role_p1(Frame& F, int wi, int nw) {
    { const CvtMat M{F.in[8], WSP(bf16, WS_BTAB), 1024, 2048, 0, 0, 16 * 32, 2048, 0}; convert_mat<false>(M, 16 * 32, wi, nw, F.lane); }
    { const CvtMat M{F.in[9], WSP(bf16, WS_BTAB), 1024, 2048, 0, 0, 16 * 32, 2048, 1024}; convert_mat<false>(M, 16 * 32, wi, nw, F.lane); }
    { const CvtMat M{F.in[10], WSP(bf16, WS_BTMIX), 2048, 2048, 0, 0, 32 * 32, 2048, 0}; convert_mat<false>(M, 32 * 32, wi, nw, F.lane); }
    { const CvtMat M{F.in[13], WSP(bf16, WS_BTXQ), 2048, 2048, 0, 0, 32 * 32, 2048, 0}; convert_mat<false>(M, 32 * 32, wi, nw, F.lane); }
    { const CvtMat M{F.in[15], WSP(bf16, WS_BTXO), 2048, 2048, 0, 0, 32 * 32, 2048, 0}; convert_mat<false>(M, 32 * 32, wi, nw, F.lane); }
    { const CvtMat M{F.in[20], WSP(bf16, WS_BTUP), 2048, 4096, 0, 1, NE * 32 * 64, 2048, 0}; convert_mat<true>(M, NE * 32 * 64, wi, nw, F.lane); }
    { const CvtMat M{F.in[22], WSP(bf16, WS_BTDN), 2048, 2048, 0, 0, NE * 32 * 32, 2048, 0}; convert_mat<true>(M, NE * 32 * 32, wi, nw, F.lane); }
}
__device__ __forceinline__ void cvt_role_p11(Frame& F, int wi, int nw) {
    const CvtMat M{F.in[22], WSP(bf16, WS_BTDN), 2048, 2048, 0, 0, NE * 32 * 32, 2048, 0}; convert_mat<true>(M, NE * 32 * 32, wi, nw, F.lane);
}
__device__ __forceinline__ int t5_bucket(int rel) {
    const int n = rel < 0 ? -rel : rel, base = rel > 0 ? 16 : 0;
    const int large = 8 + (n >= 12) + (n >= 16) + (n >= 23) + (n >= 32) + (n >= 46) + (n >= 64) + (n >= 91);
    return base + (n < 8 ? n : large);
}
__device__ __forceinline__ void load_row64(float (&q)[64], const bf16* p, float scale) {
#pragma unroll
    for (int i = 0; i < 8; ++i) { const v4u w = ((const v4u*)p)[i];
        q[8 * i + 0] = bflo(w.x) * scale; q[8 * i + 1] = bfhi(w.x) * scale; q[8 * i + 2] = bflo(w.y) * scale; q[8 * i + 3] = bfhi(w.y) * scale;
        q[8 * i + 4] = bflo(w.z) * scale; q[8 * i + 5] = bfhi(w.z) * scale; q[8 * i + 6] = bflo(w.w) * scale; q[8 * i + 7] = bfhi(w.w) * scale; }
}
__device__ __forceinline__ float dot_row64(const float (&q)[64], const bf16* p) {
    float s0 = 0.f, s1 = 0.f;
#pragma unroll
    for (int i = 0; i < 8; ++i) { const v4u w = ((const v4u*)p)[i];
        s0 += q[8 * i + 0] * bflo(w.x); s1 += q[8 * i + 1] * bfhi(w.x); s0 += q[8 * i + 2] * bflo(w.y); s1 += q[8 * i + 3] * bfhi(w.y);
        s0 += q[8 * i + 4] * bflo(w.z); s1 += q[8 * i + 5] * bfhi(w.z); s0 += q[8 * i + 6] * bflo(w.w); s1 += q[8 * i + 7] * bfhi(w.w); }
    return s0 + s1;
}
__device__ __forceinline__ void axpy_row64(float (&o)[64], float a, float p, const bf16* vp) {
#pragma unroll
    for (int i = 0; i < 8; ++i) { const v4u w = ((const v4u*)vp)[i];
        o[8 * i + 0] = o[8 * i + 0] * a + p * bflo(w.x); o[8 * i + 1] = o[8 * i + 1] * a + p * bfhi(w.x); o[8 * i + 2] = o[8 * i + 2] * a + p * bflo(w.y); o[8 * i + 3] = o[8 * i + 3] * a + p * bfhi(w.y);
        o[8 * i + 4] = o[8 * i + 4] * a + p * bflo(w.z); o[8 * i + 5] = o[8 * i + 5] * a + p * bfhi(w.z); o[8 * i + 6] = o[8 * i + 6] * a + p * bflo(w.w); o[8 * i + 7] = o[8 * i + 7] * a + p * bfhi(w.w); }
}
__device__ __forceinline__ void store_row64(const float (&o)[64], float scale, bf16* p) {
#pragma unroll
    for (int i = 0; i < 8; ++i) { v4u w; w.x = pk2(o[8 * i] * scale, o[8 * i + 1] * scale); w.y = pk2(o[8 * i + 2] * scale, o[8 * i + 3] * scale); w.z = pk2(o[8 * i + 4] * scale, o[8 * i + 5] * scale); w.w = pk2(o[8 * i + 6] * scale, o[8 * i + 7] * scale);
        ((v4u*)p)[i] = w; }
}
typedef short bf16x8 __attribute__((ext_vector_type(8)));
typedef float f32x16 __attribute__((ext_vector_type(16)));
#define MFMA32(a, b, c) __builtin_amdgcn_mfma_f32_32x32x16_bf16((a), (b), (c), 0, 0, 0)
__device__ __forceinline__ void p7_cross_mfma(Frame& F) {
    const bf16* qx = WSP(bf16, WS_QX); const bf16* kmem = WSP(bf16, WS_KMEM); const bf16* vT = WSP(bf16, WS_VT); bf16* ox = WSP(bf16, WS_OX);
    LAS unsigned char* L = F.lds + RING_OFF;
    constexpr int P_OFF = 0, P_STRIDE = 528, KV_OFF = 128 * P_STRIDE, K_STRIDE = 144, V_STRIDE = 528, ST_OFF = KV_OFF + 256 * K_STRIDE;
    static_assert(ST_OFF + 2048 <= RING_BYTES && 64 * V_STRIDE <= 256 * K_STRIDE, "cross-attention LDS map");
    const int w = F.wave, qt = w & 3, kh = w >> 2, r = F.lane & 31, h = F.lane >> 5, tid = F.tid;
    const float c2 = 0.044194173824159216f * 1.4426950408889634f;
    for (int u = F.vcu; u < 256; u += F.G) {
        const int b = u >> 7, head = (u >> 5) & 3, qblk = u & 31; const size_t row0 = (size_t)b * SEQ + qblk * 128;
        const bf16* qrow = qx + (row0 + qt * 32 + r) * D + head * 512 + 8 * h;
        const bf16* kbase = kmem + (size_t)b * MEMLEN * 2048 + head * 512;
        f32x16 sacc[4];
#pragma unroll
        for (int kt = 0; kt < 4; ++kt)
#pragma unroll
            for (int i = 0; i < 16; ++i) sacc[kt][i] = 0.f;
        v4u kst[4]; bf16x8 qf[4], qn[4];
#pragma unroll
        for (int j = 0; j < 4; ++j) { const int p = tid + 512 * j; kst[j] = *(const v4u*)(kbase + (size_t)(p >> 3) * 2048 + (p & 7) * 8); }
#pragma unroll
        for (int s = 0; s < 4; ++s) qf[s] = *(const bf16x8*)(qrow + 16 * s);
        for (int c = 0; c < 8; ++c) {
#pragma unroll
            for (int j = 0; j < 4; ++j) { const int p = tid + 512 * j; *(LAS v4u*)(L + KV_OFF + (p >> 3) * K_STRIDE + (p & 7) * 16) = kst[j]; }
            __syncthreads();
            if (c < 7) {
#pragma unroll
                for (int j = 0; j < 4; ++j) { const int p = tid + 512 * j; kst[j] = *(const v4u*)(kbase + (size_t)(p >> 3) * 2048 + (c + 1) * 64 + (p & 7) * 8); }
#pragma unroll
                for (int s = 0; s < 4; ++s) qn[s] = *(const bf16x8*)(qrow + (c + 1) * 64 + 16 * s);
            }
#pragma unroll
            for (int s = 0; s < 4; ++s)
#pragma unroll
                for (int kt = 0; kt < 4; ++kt) { const bf16x8 kf = *(const LAS bf16x8*)(L + KV_OFF + (kh * 128 + kt * 32 + r) * K_STRIDE + (16 * s + 8 * h) * 2);
                    sacc[kt] = MFMA32(kf, qf[s], sacc[kt]); }
            __syncthreads();
#pragma unroll
            for (int s = 0; s < 4; ++s) qf[s] = qn[s];
        }
        LAS float* mx = (LAS float*)(L + ST_OFF); LAS float* ls = mx + 256;
        float mloc = -3.0e38f;
#pragma unroll
        for (int kt = 0; kt < 4; ++kt)
#pragma unroll
            for (int i = 0; i < 16; ++i) mloc = fmaxf(mloc, sacc[kt][i]);
        mloc = fmaxf(mloc, __shfl_xor(mloc, 32));
        if (h == 0) mx[kh * 128 + qt * 32 + r] = mloc;
        __syncthreads();
        const float m = fmaxf(mx[qt * 32 + r], mx[128 + qt * 32 + r]);
        float lsum = 0.f;
#pragma unroll
        for (int kt = 0; kt < 4; ++kt)
#pragma unroll
            for (int i = 0; i < 16; ++i) { const float p = __builtin_amdgcn_exp2f((sacc[kt][i] - m) * c2); sacc[kt][i] = p; lsum += p; }
        lsum += __shfl_xor(lsum, 32);
        if (h == 0) ls[kh * 128 + qt * 32 + r] = lsum;
        __syncthreads();
        const float inv = 1.0f / (ls[qt * 32 + r] + ls[128 + qt * 32 + r]);
#pragma unroll
        for (int kt = 0; kt < 4; ++kt)
#pragma unroll
            for (int g = 0; g < 4; ++g) { v2u wv; wv.x = pk2(sacc[kt][4 * g] * inv, sacc[kt][4 * g + 1] * inv); wv.y = pk2(sacc[kt][4 * g + 2] * inv, sacc[kt][4 * g + 3] * inv);
                *(LAS v2u*)(L + P_OFF + (qt * 32 + r) * P_STRIDE + (kh * 128 + kt * 32 + 8 * g + 4 * h) * 2) = wv; }
        __syncthreads();
        bf16x8 pf[16];
#pragma unroll
        for (int s = 0; s < 16; ++s) pf[s] = *(const LAS bf16x8*)(L + P_OFF + (qt * 32 + r) * P_STRIDE + (16 * s + 8 * h) * 2);
        const bf16* vbase = vT + (size_t)head * 512 * 512 + b * MEMLEN;
        v4u vst[4];
#pragma unroll
        for (int j = 0; j < 4; ++j) { const int p = tid + 512 * j, row = p >> 5; vst[j] = *(const v4u*)(vbase + (size_t)((row >> 5) * 256 + (row & 31)) * 512 + (p & 31) * 8); }
        for (int i = 0; i < 8; ++i) {
#pragma unroll
            for (int j = 0; j < 4; ++j) { const int p = tid + 512 * j; *(LAS v4u*)(L + KV_OFF + (p >> 5) * V_STRIDE + (p & 31) * 16) = vst[j]; }
            __syncthreads();
            if (i < 7) {
#pragma unroll
                for (int j = 0; j < 4; ++j) { const int p = tid + 512 * j, row = p >> 5; vst[j] = *(const v4u*)(vbase + (size_t)((row >> 5) * 256 + (i + 1) * 32 + (row & 31)) * 512 + (p & 31) * 8); }
            }
            f32x16 acc;
#pragma unroll
            for (int k = 0; k < 16; ++k) acc[k] = 0.f;
#pragma unroll
            for (int s = 0; s < 16; ++s) { const bf16x8 vf = *(const LAS bf16x8*)(L + KV_OFF + (kh * 32 + r) * V_STRIDE + (16 * s + 8 * h) * 2); acc = MFMA32(vf, pf[s], acc); }
            bf16* op = ox + (row0 + qt * 32 + r) * D + head * 512 + (kh * 8 + i) * 32 + 4 * h;
#pragma unroll
            for (int g = 0; g < 4; ++g) { v2u wv; wv.x = pk2(acc[4 * g], acc[4 * g + 1]); wv.y = pk2(acc[4 * g + 2], acc[4 * g + 3]); *(v2u*)(op + 8 * g) = wv; }
            __syncthreads();
        }
    }
}
__device__ __forceinline__ int crow16(int i, int hh) { return (i & 3) + 8 * (i >> 2) + 4 * hh; }
__device__ __forceinline__ bf16x8 pack8(const f32x16& x, int s) {
    v4u p; p.x = pk2(x[8 * s], x[8 * s + 1]); p.y = pk2(x[8 * s + 2], x[8 * s + 3]); p.z = pk2(x[8 * s + 4], x[8 * s + 5]); p.w = pk2(x[8 * s + 6], x[8 * s + 7]);
    return __builtin_bit_cast(bf16x8, p);
}
__device__ __forceinline__ bf16x8 vt_frag(const LAS unsigned char* p) {
    const v2u lo = *(const LAS v2u*)p, hi = *(const LAS v2u*)(p + 16); v4u w; w.x = lo.x; w.y = lo.y; w.z = hi.x; w.w = hi.y; return __builtin_bit_cast(bf16x8, w);
}
__device__ __forceinline__ void vt_scatter(LAS unsigned char* vt, int stride, int c16, int key, v4u w) {
    LAS unsigned short* p = (LAS unsigned short*)(vt + (c16 * 8) * stride + key * 2); const int st = stride / 2;
    p[0] = (unsigned short)w.x; p[st] = (unsigned short)(w.x >> 16); p[2 * st] = (unsigned short)w.y; p[3 * st] = (unsigned short)(w.y >> 16);
    p[4 * st] = (unsigned short)w.z; p[5 * st] = (unsigned short)(w.z >> 16); p[6 * st] = (unsigned short)w.w; p[7 * st] = (unsigned short)(w.w >> 16);
}
__device__ __forceinline__ void p2_swa_mfma(Frame& F, int uc, int uG) {
    const bf16* proj = WSP(bf16, WS_PROJ); bf16* oa = WSP(bf16, WS_OAB);
    const float* relb = F.in[4]; const float* sinks = F.in[7];
    LAS unsigned char* L = F.lds + RING_OFF;
    constexpr int K_OFF = 0, K_STRIDE = 144, VT_OFF = 192 * K_STRIDE, VT_STRIDE = 392, BT_OFF = VT_OFF + 64 * VT_STRIDE;
    static_assert(BT_OFF + 8 * 256 * 4 <= RING_BYTES && BT_OFF % 16 == 0, "swa LDS map");
    const int w = F.wave, r = F.lane & 31, hh = F.lane >> 5, tid = F.tid;
    for (int u = uc; u < 256; u += uG) {
        const int b = u >> 7, g = (u >> 6) & 1, c = u & 63, h = g * 8 + w;
        const int k_lo = (c >= 2 ? c - 2 : 0) * 64, nk = c * 64 + 64 - k_lo, nkt = nk >> 5;
        const bf16* kvbase = proj + ((size_t)b * SEQ + k_lo) * NIN + g * 64;
#pragma unroll
        for (int j = 0; j < 3; ++j) { const int p = tid + 512 * j;
            if (p < nk * 8) { const int key = p >> 3, c16 = p & 7; const bf16* src = kvbase + (size_t)key * NIN + c16 * 8;
                *(LAS v4u*)(L + K_OFF + key * K_STRIDE + c16 * 16) = *(const v4u*)(src + C_KA);
                vt_scatter(L + VT_OFF, VT_STRIDE, c16, key, *(const v4u*)(src + C_VA)); } }
        LAS float* tab = (LAS float*)(L + BT_OFF) + w * 256;
#pragma unroll
        for (int j = 0; j < 4; ++j) { const int idx = F.lane + 64 * j; if (idx < 255) tab[idx] = relb[t5_bucket(idx - 191) * 16 + h]; }
        __syncthreads();
        const float sink = sinks[h];
        const int ibase = k_lo - c * 64 + 191;
#pragma unroll 1
        for (int qt = 0; qt < 2; ++qt) {
            const size_t row = (size_t)b * SEQ + c * 64 + qt * 32 + r;
            bf16x8 qf[4];
#pragma unroll
            for (int s = 0; s < 4; ++s) qf[s] = *(const bf16x8*)(proj + row * NIN + C_QA + h * 64 + 16 * s + 8 * hh);
            f32x16 sacc[6];
#pragma unroll
            for (int kt = 0; kt < 6; ++kt)
#pragma unroll
                for (int i = 0; i < 16; ++i) sacc[kt][i] = 0.f;
#pragma unroll
            for (int kt = 0; kt < 6; ++kt) if (kt < nkt) {
#pragma unroll
                for (int s = 0; s < 4; ++s) { const bf16x8 kf = *(const LAS bf16x8*)(L + K_OFF + (kt * 32 + r) * K_STRIDE + (16 * s + 8 * hh) * 2); sacc[kt] = MFMA32(kf, qf[s], sacc[kt]); } }
            float m = sink;
#pragma unroll
            for (int kt = 0; kt < 6; ++kt) if (kt < nkt) {
#pragma unroll
                for (int i = 0; i < 16; ++i) { const float sv = sacc[kt][i] * 0.125f + tab[ibase + kt * 32 + crow16(i, hh) - qt * 32 - r]; sacc[kt][i] = sv; m = fmaxf(m, sv); } }
            m = fmaxf(m, __shfl_xor(m, 32));
            float lsum = 0.f;
#pragma unroll
            for (int kt = 0; kt < 6; ++kt) if (kt < nkt) {
#pragma unroll
                for (int i = 0; i < 16; ++i) { const float p = __expf(sacc[kt][i] - m); sacc[kt][i] = p; lsum += p; } }
            lsum += __shfl_xor(lsum, 32);
            const float inv = 1.0f / (lsum + __expf(sink - m));
            f32x16 oacc[2];
#pragma unroll
            for (int dt = 0; dt < 2; ++dt)
#pragma unroll
                for (int i = 0; i < 16; ++i) oacc[dt][i] = 0.f;
#pragma unroll
            for (int kt = 0; kt < 6; ++kt) if (kt < nkt) {
#pragma unroll
                for (int i = 0; i < 16; ++i) sacc[kt][i] *= inv;
#pragma unroll
                for (int s = 0; s < 2; ++s) { const bf16x8 pf = pack8(sacc[kt], s);
#pragma unroll
                    for (int dt = 0; dt < 2; ++dt) { const bf16x8 vf = vt_frag(L + VT_OFF + (dt * 32 + r) * VT_STRIDE + (kt * 32 + 16 * s + 4 * hh) * 2); oacc[dt] = MFMA32(vf, pf, oacc[dt]); } } }
            bf16* op = oa + row * 2048 + h * 64 + 4 * hh;
#pragma unroll
            for (int dt = 0; dt < 2; ++dt)
#pragma unroll
                for (int gq = 0; gq < 4; ++gq) { v2u wv; wv.x = pk2(oacc[dt][4 * gq], oacc[dt][4 * gq + 1]); wv.y = pk2(oacc[dt][4 * gq + 2], oacc[dt][4 * gq + 3]); *(v2u*)(op + dt * 32 + 8 * gq) = wv; }
        }
        __syncthreads();
    }
}
__device__ __forceinline__ void p2_sb_mfma(Frame& F, int uc, int uG) {
    const bf16* proj = WSP(bf16, WS_PROJ); bf16* ob = WSP(bf16, WS_OAB) + 1024;
    LAS unsigned char* L = F.lds + RING_OFF;
    constexpr int K_OFF = 0, K_STRIDE = 144, VT_OFF = 448 * K_STRIDE, VT_STRIDE = 904, FL_OFF = VT_OFF + 64 * VT_STRIDE;
    static_assert(FL_OFF + 64 <= RING_BYTES && VT_OFF % 16 == 0, "sb LDS map");
    const int w = F.wave, r = F.lane & 31, hh = F.lane >> 5, tid = F.tid;
    const float LOG2E = 1.4426950408889634f, LN2 = 0.6931471805599453f;
    for (int u = uc; u < 512; u += uG) {
        const int b = u >> 8, h = (u >> 4) & 15, qb = u & 15, q0 = qb * 256, tstart = q0 + 32 * w, t = tstart + r;
        const size_t row = (size_t)b * SEQ + t;
        bf16x8 qf[4];
#pragma unroll
        for (int s = 0; s < 4; ++s) qf[s] = *(const bf16x8*)(proj + row * NIN + C_QB + h * 64 + 16 * s + 8 * hh);
        f32x16 oacc[2];
#pragma unroll
        for (int dt = 0; dt < 2; ++dt)
#pragma unroll
            for (int i = 0; i < 16; ++i) oacc[dt][i] = 0.f;
        float R = 0.f; bool done = false;
        int whi = q0 + 256, wlo = q0 >= 192 ? q0 - 192 : 0;
        for (;;) {
            const int nk = whi - wlo; const bf16* kvbase = proj + ((size_t)b * SEQ + wlo) * NIN + h * 64;
#pragma unroll
            for (int j = 0; j < 7; ++j) { const int p = tid + 512 * j;
                if (p < nk * 8) { const int key = p >> 3, c16 = p & 7; const bf16* src = kvbase + (size_t)key * NIN + c16 * 8;
                    *(LAS v4u*)(L + K_OFF + key * K_STRIDE + c16 * 16) = *(const v4u*)(src + C_KB);
                    vt_scatter(L + VT_OFF, VT_STRIDE, c16, key, *(const v4u*)(src + C_VB)); } }
            __syncthreads();
            for (int kb = (whi - 32 < tstart ? whi - 32 : tstart); kb >= wlo && !done; kb -= 32) {
                const int kl = kb - wlo;
                f32x16 sacc;
#pragma unroll
                for (int i = 0; i < 16; ++i) sacc[i] = 0.f;
#pragma unroll
                for (int s = 0; s < 4; ++s) { const bf16x8 kf = *(const LAS bf16x8*)(L + K_OFF + (kl + r) * K_STRIDE + (16 * s + 8 * hh) * 2); sacc = MFMA32(kf, qf[s], sacc); }
                float sp[16];
#pragma unroll
                for (int i = 0; i < 16; ++i) { const float z = sacc[i] * 0.125f; const bool on = (kb + crow16(i, hh)) < t;
                    const float e = __builtin_amdgcn_exp2f(-fabsf(z) * LOG2E);
                    const float spv = fmaxf(z, 0.f) + LN2 * __builtin_amdgcn_logf(1.0f + e);
                    sp[i] = on ? spv : 0.f; sacc[i] = on ? z - spv : -1.0e30f; }
                float gs[4], ot[4];
#pragma unroll
                for (int gq = 0; gq < 4; ++gq) { gs[gq] = (sp[4 * gq] + sp[4 * gq + 1]) + (sp[4 * gq + 2] + sp[4 * gq + 3]); ot[gq] = __shfl_xor(gs[gq], 32); }
                const float ps3 = gs[3] + ot[3], ps2 = gs[2] + ot[2], ps1 = gs[1] + ot[1], ps0 = gs[0] + ot[0];
                float ge[4];
                ge[3] = (hh == 0 ? ot[3] : 0.f); ge[2] = (hh == 0 ? ot[2] : 0.f) + ps3; ge[1] = (hh == 0 ? ot[1] : 0.f) + ps3 + ps2; ge[0] = (hh == 0 ? ot[0] : 0.f) + ps3 + ps2 + ps1;
#pragma unroll
                for (int gq = 0; gq < 4; ++gq) {
                    const float base = R - ge[gq];
                    const float e3 = base, e2 = e3 - sp[4 * gq + 3], e1 = e2 - sp[4 * gq + 2], e0 = e1 - sp[4 * gq + 1];
                    sacc[4 * gq + 3] = __builtin_amdgcn_exp2f((sacc[4 * gq + 3] + e3) * LOG2E); sacc[4 * gq + 2] = __builtin_amdgcn_exp2f((sacc[4 * gq + 2] + e2) * LOG2E);
                    sacc[4 * gq + 1] = __builtin_amdgcn_exp2f((sacc[4 * gq + 1] + e1) * LOG2E); sacc[4 * gq] = __builtin_amdgcn_exp2f((sacc[4 * gq] + e0) * LOG2E); }
                R -= (ps0 + ps1) + (ps2 + ps3);
#pragma unroll
                for (int s = 0; s < 2; ++s) { const bf16x8 pf = pack8(sacc, s);
#pragma unroll
                    for (int dt = 0; dt < 2; ++dt) { const bf16x8 vf = vt_frag(L + VT_OFF + (dt * 32 + r) * VT_STRIDE + (kl + 16 * s + 4 * hh) * 2); oacc[dt] = MFMA32(vf, pf, oacc[dt]); } }
                done = __all(R < -104.0f);
            }
            LAS unsigned* fl = (LAS unsigned*)(L + FL_OFF);
            if (F.lane == 0) fl[w] = done ? 1u : 0u;
            __syncthreads();
            bool alld = true;
#pragma unroll
            for (int i = 0; i < 8; ++i) alld = alld && (fl[i] != 0u);
            __syncthreads();
            if (alld || wlo == 0) break;
            whi = wlo; wlo = whi >= 448 ? whi - 448 : 0;
        }
        bf16* op = ob + row * 2048 + h * 64 + 4 * hh;
#pragma unroll
        for (int dt = 0; dt < 2; ++dt)
#pragma unroll
            for (int gq = 0; gq < 4; ++gq) { v2u wv; wv.x = pk2(oacc[dt][4 * gq], oacc[dt][4 * gq + 1]); wv.y = pk2(oacc[dt][4 * gq + 2], oacc[dt][4 * gq + 3]); *(v2u*)(op + dt * 32 + 8 * gq) = wv; }
    }
}
__device__ __forceinline__ void p_ln(Frame& F, const float* src, const float* g, const float* b, float* dstf, bf16* dstb) {
    const int gw = F.vcu * NWAVES + F.wave, NGW = F.G * NWAVES;
    for (int m = gw; m < T; m += NGW) {
        f32x4 v[8]; row_load(v, src + (size_t)m * D, F.lane);
        ln_row(v, g, b, F.lane);
        row_store_f32(v, dstf + (size_t)m * D, F.lane);
        row_store_bf16(v, dstb + (size_t)m * D, F.lane);
    }
}
__device__ __forceinline__ void p9_ln_router(Frame& F) {
    const float* wr = F.in[18]; const float* br = F.in[19];
    int* tok_e = WSP(int, WS_ROUTE); float* tok_g = WSP(float, WS_ROUTE + 131072); int* tok_pos = WSP(int, WS_ROUTE + 262144);
    float* h2f = WSP(float, WS_H2F);
    LAS float* part = (LAS float*)(F.lds + RING_OFF);
    LAS unsigned* lcnt = (LAS unsigned*)(F.lds + RING_OFF + 32768); LAS unsigned* lbase = lcnt + 32; LAS unsigned* lpe = lcnt + 64;
    if (F.tid < 32) lcnt[F.tid] = 0u;
    __syncthreads();
    const int w = F.wave, e = F.lane & 31, hh = F.lane >> 5;
    for (int u = F.vcu; u < T / 32; u += F.G) {
        const int tok0 = u * 32;
#pragma unroll 1
        for (int q = 0; q < 4; ++q) { const int m = tok0 + 4 * w + q;
            f32x4 v[8]; row_load(v, WSP(float, WS_S1) + (size_t)m * D, F.lane);
            ln_row(v, F.in[16], F.in[17], F.lane);
            row_store_f32(v, h2f + (size_t)m * D, F.lane);
            row_store_bf16(v, WSP(bf16, WS_H2B) + (size_t)m * D, F.lane);
            { unsigned* o8 = WSP(unsigned, WS_XS) + (size_t)m * (D / 4);
#pragma unroll
              for (int j = 0; j < 8; ++j) o8[F.lane + 64 * j] = pk4_fp8(v[j][0], v[j][1], v[j][2], v[j][3]); } }
        __syncthreads();
        f32x16 acc;
#pragma unroll
        for (int i = 0; i < 16; ++i) acc[i] = 0.f;
        const float* ap = h2f + (size_t)(tok0 + e) * D + 256 * w + 4 * hh;
        const float* bp = wr + (size_t)(256 * w + 4 * hh) * NE + e;
#pragma unroll 4
        for (int m = 0; m < 32; ++m) { const f32x4 a4 = *(const f32x4*)(ap + 8 * m);
#pragma unroll
            for (int j = 0; j < 4; ++j) acc = __builtin_amdgcn_mfma_f32_32x32x2f32(a4[j], bp[(size_t)(8 * m + j) * NE], acc, 0, 0, 0); }
#pragma unroll
        for (int i = 0; i < 16; ++i) part[(w * 32 + crow16(i, hh)) * 32 + e] = acc[i];
        __syncthreads();
        const float bias = br[e];
#pragma unroll 1
        for (int q = 0; q < 4; ++q) { const int tl = 4 * w + q, m = tok0 + tl;
            float val = bias;
#pragma unroll
            for (int ww = 0; ww < 8; ++ww) val += part[(ww * 32 + tl) * 32 + e];
            float tv[4]; int ti[4];
#pragma unroll
            for (int p = 0; p < 4; ++p) {
                float bv = val; int bi = e;
#pragma unroll
                for (int off = 1; off < 32; off <<= 1) { const float ov = __shfl_xor(bv, off); const int oi = __shfl_xor(bi, off);
                    const bool take = (ov > bv) || (ov == bv && oi < bi); bv = take ? ov : bv; bi = take ? oi : bi; }
                tv[p] = bv; ti[p] = bi;
                val = (e == bi) ? -3.0e38f : val;
            }
            const float e1 = __expf(tv[1] - tv[0]), e2 = __expf(tv[2] - tv[0]), e3 = __expf(tv[3] - tv[0]);
            const float inv = 1.0f / (1.0f + e1 + e2 + e3);
            if (F.lane < 4) {
                const int my_e = F.lane == 0 ? ti[0] : F.lane == 1 ? ti[1] : F.lane == 2 ? ti[2] : ti[3];
                const float my_g = (F.lane == 0 ? 1.0f : F.lane == 1 ? e1 : F.lane == 2 ? e2 : e3) * inv;
                const unsigned lpos = __hip_atomic_fetch_add((LAS unsigned*)&lcnt[my_e], 1u, __ATOMIC_RELAXED, __HIP_MEMORY_SCOPE_WORKGROUP);
                tok_e[m * 4 + F.lane] = my_e; tok_g[m * 4 + F.lane] = my_g; lpe[tl * 4 + F.lane] = (unsigned)my_e | (lpos << 8);
            } }
        __syncthreads();
        if (F.tid < 32) { const unsigned c = lcnt[F.tid]; lbase[F.tid] = c ? __hip_atomic_fetch_add((unsigned*)(F.ctl + CW_CNT + 64 * F.tid), c, RLX_AGENT) : 0u; }
        __syncthreads();
        if (F.tid < 128) { const unsigned x = lpe[F.tid]; tok_pos[tok0 * 4 + F.tid] = (int)(lbase[x & 255u] + (x >> 8)); }
        if (F.tid < 32) lcnt[F.tid] = 0u;
        __syncthreads();
    }
}
__device__ __forceinline__ void p10_scatter(Frame& F) {
    const int gw = F.vcu * NWAVES + F.wave, NGW = F.G * NWAVES;
    LAS int* poff = (LAS int*)(F.lds + RING_OFF);
    int* tab = WSP(int, WS_TAB);
    LAS int* lc = poff + 40;
    if (F.tid < NE) lc[F.tid] = (int)__hip_atomic_load((unsigned*)(F.ctl + CW_CNT + 64 * F.tid), RLX_AGENT);
    __syncthreads();
    if (F.tid == 0) {
        int acc = 0;
        int nbig = 0, nsml = 0;
        for (int e = 0; e < NE; ++e) { const int c = lc[e]; poff[e] = acc;
            const int nt = (c + 255) >> 8;
            if (blockIdx.x == 0) for (int k = 0; k < nt; ++k) { const int t = (acc >> 8) + k; tab[t] = e;
                if (c - 256 * k > 128) tab[256 + nbig++] = t; else tab[448 + nsml++] = t; }
            acc += nt << 8; }
        poff[32] = acc;
        if (blockIdx.x == 0) { tab[192] = acc >> 8; tab[193] = nbig; for (int k = 0; k < nsml; ++k) tab[256 + nbig + k] = tab[448 + k]; }
    }
    __syncthreads();
    if (blockIdx.x == 0) {
        const int rt = poff[32] >> 8;
        for (int pass = 0; pass < 2; ++pass) { const int nN = pass ? 8 : 16, nwg = rt * nN; int* ul = tab + (pass ? 8192 : 1024);
            for (int L = F.tid; L < nwg; L += NWAVES * 64) {
                const int q = nwg / 8, r8 = nwg % 8, xcd = L % 8, off = L / 8; const int wgid = (xcd < r8 ? xcd * (q + 1) : r8 * (q + 1) + (xcd - r8) * q) + off;
                int e = 0;
                for (int k = 1; k < NE; ++k) e = (wgid >= (poff[k] >> 8) * nN) ? k : e;
                const int first = poff[e] >> 8, re = (poff[e + 1] >> 8) - first, local = wgid - first * nN;
                ul[L] = (first + local % re) | ((e * nN + local / re) << 16); } }
    }
    const int* tok_e = WSP(int, WS_ROUTE); const int* tok_pos = WSP(int, WS_ROUTE + 262144); int* tok_row = WSP(int, WS_ROUTE + 393216);
    int* rowtok = WSP(int, WS_XS + 32 * MiB);
    const int gt = F.vcu * NWAVES * 64 + F.tid, NT = F.G * NWAVES * 64;
    for (int p = gt; p < T * 4; p += NT) { const int e = tok_e[p], row = poff[e] + tok_pos[p]; tok_row[p] = row; rowtok[row] = p >> 2; }
    for (int e = 0; e < NE; ++e) { const int c0 = poff[e] + lc[e], c1 = poff[e + 1]; for (int r = c0 + gt; r < c1; r += NT) rowtok[r] = 0; }
    __syncthreads();
}
__device__ __forceinline__ void p13_combine(Frame& F) {
    const int gw = F.vcu * NWAVES + F.wave, NGW = F.G * NWAVES;
    const float* tok_g = WSP(float, WS_ROUTE + 131072); const int* tok_row = WSP(int, WS_ROUTE + 393216);
    const bf16* yr = WSP(bf16, WS_YR);
    for (int m = gw; m < T; m += NGW) {
        f32x4 v[8]; row_load(v, WSP(float, WS_H2F) + (size_t)m * D, F.lane);
#pragma unroll
        for (int j = 0; j < 8; ++j) v[j] = v[j] * ALPHA;
#pragma unroll
        for (int k = 0; k < 4; ++k) { const float g = tok_g[m * 4 + k]; const v2u* yp = (const v2u*)(yr + (size_t)tok_row[m * 4 + k] * D);
#pragma unroll
            for (int j = 0; j < 8; ++j) { const v2u w = yp[F.lane + 64 * j]; v[j][0] += g * bflo(w.x); v[j][1] += g * bfhi(w.x); v[j][2] += g * bflo(w.y); v[j][3] += g * bfhi(w.y); } }
        ln_row(v, F.in[24], F.in[25], F.lane);
        row_store_f32(v, F.out + (size_t)m * D, F.lane);
    }
}

struct Args { const float* in[26]; float* out; unsigned char* ws; int ph_lo, ph_hi; };
__global__ void __launch_bounds__(NWAVES * 64, 2) mk_fwd(Args args) {
    extern __shared__ __attribute__((aligned(16))) unsigned char lds[];
    Frame F;
    F.lds = (LAS unsigned char*)lds;
    F.MISC = (volatile LAS unsigned*)(F.lds + MISC_OFF);
    F.tid = threadIdx.x; F.lane = F.tid & 63; F.wave = __builtin_amdgcn_readfirstlane(F.tid >> 6);
    F.G = gridDim.x; { const int bx = blockIdx.x; F.vcu = (F.G % 8 == 0) ? (bx % 8) * (F.G / 8) + bx / 8 : bx; }
    F.ws = args.ws; F.out = args.out;
    F.in = args.in;
    F.ctl = (gu32*)(F.ws + WS_CTL);
    for (int u = F.tid; u < (LDS_BYTES - LDSCTL_OFF) / 4; u += NWAVES * 64) ((LAS unsigned*)(F.lds + LDSCTL_OFF))[u] = 0u;
    __syncthreads();
    const int lo = args.ph_lo, hi = args.ph_hi;
    const bool multi = (hi - lo) > 1;
    XcdBarrier bar; bar.bar = (unsigned*)(F.ctl + CW_BAR); bar.x = 0; bar.st = nullptr;
    if (multi) bar = xcd_barrier_post((unsigned*)(F.ctl + CW_BAR), F.MISC + 8);
#ifndef P1_CW
#define P1_CW 18
#endif
#ifndef P11_CW
#define P11_CW 28
#endif
#ifndef REPEAT_MASK
#define REPEAT_MASK 0u
#endif
#ifndef PHMASK
#define PHMASK 0xffffffffu
#endif
#define IN(k) ((((PHMASK) >> (k)) & 1u) && lo <= (k) && (k) < hi)
#define RUN(k, ...) do { if (IN(k)) __VA_ARGS__ if (((REPEAT_MASK >> (k)) & 1u) && IN(k)) __VA_ARGS__ } while (0);
#define SEAM(k) do { if (IN(k) && IN((k) + 1)) xcd_barrier(bar); } while (0)
    const int G = F.G, cidx = (int)blockIdx.x;

    RUN(0, { p0_prologue(F); }) SEAM(0);
    const int xi = cidx & 7, pi = cidx >> 3, per_x = G >> 3;
    RUN(1, {
        const bool split = (G % 8 == 0) && per_x > P1_CW;
        if (!split) { cvt_role_p1(F, F.vcu * NWAVES + F.wave, G * NWAVES); if (multi) xcd_barrier(bar); }
        if (!split || pi < P1_CW) {
            pg8::Gemm g{(const bf16*)F.ws, (const bf16*)F.ws, T + 512, NIN + 4096, D}; blk::SchedP1 S; S.init(split ? P1_CW * 8 : G, split ? pi * 8 + xi : cidx);
            blk::EpiProj E{F.ws, F.in[6]};
            pg8::gemm_phase<blk::EpiProj, blk::SchedP1, true, true>(F.lds + RING_OFF, g, S, E);
            if (split) {
                VM_WAIT(); __syncthreads();
                if (F.tid == 0) {
                    __builtin_amdgcn_fence(__ATOMIC_RELEASE, "agent"); VM_WAIT();
                    gu32* cnt = F.ctl + CW_SUB; const unsigned want = (unsigned)(P1_CW * 8);
                    __hip_atomic_fetch_add(cnt, 1u, RLX_AGENT);
                    unsigned sp = 0;
                    while (__hip_atomic_load(cnt, RLX_AGENT) < want) { __builtin_amdgcn_s_sleep(2);
                        if ((++sp & 255u) == 0u) { if (__hip_atomic_load(F.ctl + CW_TMO, RLX_AGENT)) break; if (sp > (1u << 20)) { __hip_atomic_store(F.ctl + CW_TMO, 1u, RLX_AGENT); break; } } }
                    __builtin_amdgcn_fence(__ATOMIC_ACQUIRE, "agent"); VM_WAIT();
                }
                __syncthreads();
                p2_swa_mfma(F, xi * P1_CW + pi, P1_CW * 8); p2_sb_mfma(F, xi * P1_CW + pi, P1_CW * 8);
            }
        } else cvt_role_p1(F, ((pi - P1_CW) * 8 + xi) * NWAVES + F.wave, (per_x - P1_CW) * 8 * NWAVES);
    }) SEAM(1);
    if (!((G % 8 == 0) && per_x > P1_CW)) { RUN(2, { p2_swa_mfma(F, F.vcu, G); p2_sb_mfma(F, F.vcu, G); }) SEAM(2); }
    RUN(3, {
        pg8::Gemm g{WSP(bf16, WS_OAB), WSP(bf16, WS_BTAB), T, D, D}; pg8::StaticOrder S; S.init(T, D, G, cidx);
        blk::EpiGate E{WSP(bf16, WS_PROJ), WSP(bf16, WS_GG)};
        pg8::gemm_phase<blk::EpiGate, pg8::StaticOrder, true, true, false, false, true>(F.lds + RING_OFF, g, S, E);
    }) SEAM(3);
    RUN(4, {
        pg8::Gemm g{WSP(bf16, WS_GG), WSP(bf16, WS_BTMIX), T, D, D}; pg8::StaticOrder S; S.init(T, D, G, cidx);
        blk::EpiRes E{WSP(float, WS_H0F), WSP(float, WS_S1)};
        pg8::gemm_phase<blk::EpiRes, pg8::StaticOrder, true, true>(F.lds + RING_OFF, g, S, E);
    }) SEAM(4);
    RUN(5, { p_ln(F, WSP(float, WS_S1), F.in[11], F.in[12], WSP(float, WS_H1F), WSP(bf16, WS_H1B)); }) SEAM(5);
    RUN(6, {
        pg8::Gemm g{WSP(bf16, WS_H1B), WSP(bf16, WS_BTXQ), T, D, D}; pg8::StaticOrder S; S.init(T, D, G, cidx);
        blk::EpiBf16B E{WSP(bf16, WS_QX), D, nullptr, 0x7fffffff, 31, 0, 1.0f};
        pg8::gemm_phase<blk::EpiBf16B, pg8::StaticOrder, true, true>(F.lds + RING_OFF, g, S, E);
    }) SEAM(6);
    RUN(7, { p7_cross_mfma(F); }) SEAM(7);
    RUN(8, {
        pg8::Gemm g{WSP(bf16, WS_OX), WSP(bf16, WS_BTXO), T, D, D}; pg8::StaticOrder S; S.init(T, D, G, cidx);
        blk::EpiRes E{WSP(float, WS_H1F), WSP(float, WS_S1)};
        pg8::gemm_phase<blk::EpiRes, pg8::StaticOrder, true, true>(F.lds + RING_OFF, g, S, E);
    }) SEAM(8);
    RUN(9, { p9_ln_router(F); }) SEAM(9);
    RUN(10, { p10_scatter(F); }) SEAM(10);
    RUN(11, {
        pg8::Gemm g{WSP(bf16, WS_XS), WSP(bf16, WS_BTUP), RMAX, NE * 4096, D}; blk::SchedMoE S; S.init(WSP(int, WS_TAB), 16, G, cidx, (LAS int*)(F.lds + MISC_OFF + 256), F.tid, WSP(int, WS_XS + 32 * MiB));
        blk::EpiSwiGLU E{WSP(unsigned char, WS_ACT), F.in[21]};
        pg8::gemm_phase<blk::EpiSwiGLU, blk::SchedMoE, true, true, false, true, false, true>(F.lds + RING_OFF, g, S, E);
    }) SEAM(11);
    RUN(12, {
        pg8::Gemm g{WSP(bf16, WS_ACT), WSP(bf16, WS_BTDN), RMAX, NE * 2048, FF}; blk::SchedMoE S; S.init(WSP(int, WS_TAB), 8, G, cidx, (LAS int*)(F.lds + MISC_OFF + 256), F.tid);
        blk::EpiBf16B E{WSP(bf16, WS_YR), D, F.in[23], 7, 3, 2048, W8_INV};
        pg8::gemm_phase<blk::EpiBf16B, blk::SchedMoE, true, true, false, true>(F.lds + RING_OFF, g, S, E);
    }) SEAM(12);
    RUN(13, { p13_combine(F); })
#undef IN
#undef SEAM
}

extern "C" void kernel_launch(void* const* d_in, const int* in_sizes, int n_in, void* d_out, int out_size, void* d_ws, size_t ws_size, hipStream_t stream) {
    static int grid = 0;
    if (grid == 0) {
        if (n_in != 26 || out_size != T * D || ws_size < WS_END) { fprintf(stderr, "kernel_launch: unexpected shapes: n_in %d out %d ws %zu (need %zu)\n", n_in, out_size, ws_size, (size_t)WS_END); grid = -1; return; }
        int dev = 0, cus = 0, per_cu = 0;
        if (hipGetDevice(&dev) != hipSuccess || hipDeviceGetAttribute(&cus, hipDeviceAttributeMultiprocessorCount, dev) != hipSuccess) { grid = -1; return; }
        if (hipFuncSetAttribute((const void*)mk_fwd, hipFuncAttributeMaxDynamicSharedMemorySize, LDS_BYTES) != hipSuccess) { fprintf(stderr, "kernel_launch: hipFuncSetAttribute failed\n"); grid = -1; return; }
        if (hipOccupancyMaxActiveBlocksPerMultiprocessor(&per_cu, (const void*)mk_fwd, NWAVES * 64, LDS_BYTES) != hipSuccess || per_cu < 1)
            fprintf(stderr, "kernel_launch: occupancy query reports %d workgroups per CU\n", per_cu);
        (void)hipGetLastError();
        grid = cus;
    }
    if (grid < 0) return;
    if (hipMemsetAsync((char*)d_ws + WS_CTL, 0, CTL_ZERO_BYTES, stream) != hipSuccess) return;
    Args a{};
    for (int i = 0; i < 26; ++i) a.in[i] = (const float*)d_in[i];
    a.out = (float*)d_out; a.ws = (unsigned char*)d_ws;
#if MK_ONE_LAUNCH
    a.ph_lo = 0; a.ph_hi = NPHASE;
    hipLaunchKernelGGL(mk_fwd, dim3(grid), dim3(NWAVES * 64), LDS_BYTES, stream, a);
#else
    for (int ph = 0; ph < NPHASE; ++ph) { a.ph_lo = ph; a.ph_hi = ph + 1;
        hipLaunchKernelGGL(mk_fwd, dim3(grid), dim3(NWAVES * 64), LDS_BYTES, stream, a); }
#endif
}
```

```cpp
#include <hip/hip_runtime.h>
#include <cstdio>
#include <cstdint>
namespace pg8 {
#define PG8_LAS __attribute__((address_space(3)))
typedef unsigned short bf16_t;
typedef short bf16x8 __attribute__((ext_vector_type(8)));
typedef float f32x4 __attribute__((ext_vector_type(4)));
typedef unsigned u32x4 __attribute__((ext_vector_type(4)));
constexpr int BM = 256, BK = 64, HALF = 128, HTB = HALF * BK * 2  , STAGE_BYTES = 8 * HTB, NXCD = 8, WGM = 8;

__host__ __device__ __forceinline__ int lds_byte(int r, int c) { const int st = (r >> 4) * 2 + (c >> 5), rr = r & 15, cc = c & 31, ob = rr * 64 + cc * 2; return st * 1024 + (ob ^ (((ob >> 9) & 1) << 5)); }
__host__ __device__ __forceinline__ void stage_rc(int b, int& R, int& C) { const int st = b / 1024, sb = b % 1024, swz = sb ^ (((sb >> 9) & 1) << 5); R = (st >> 1) * 16 + swz / 64; C = (st & 1) * 32 + (swz % 64) / 2; }
__host__ __device__ __forceinline__ int perm32(int rho) { const int n = rho >> 4, i = rho & 15; return 8 * (i >> 2) + 4 * n + (i & 3); }

struct Unit { int pm, pn, rm, rn; };
struct Gemm { const bf16_t* A; const bf16_t* Bt; int M, N, K; };

struct StaticOrder {
    int nM, nN, nwg, G, c;
    __host__ __device__ void init(int M, int N, int G_, int c_) { nM = M / BM; nN = N / BM; nwg = nM * nN; G = G_; c = c_; }
    __host__ __device__ __forceinline__ bool next(int i, Unit& u) const {
        const long L = (long)i * G + c; if (L >= nwg) return false;
        int wgid = (int)L; { const int q = nwg / NXCD, r = nwg % NXCD, xcd = wgid % NXCD, off = wgid / NXCD; wgid = (xcd < r ? xcd * (q + 1) : r * (q + 1) + (xcd - r) * q) + off; }
        const int nig = WGM * nN, gid = wgid / nig, fm = gid * WGM, gsz = (nM - fm) < WGM ? (nM - fm) : WGM;
        u.pm = fm + ((wgid % nig) % gsz); u.pn = (wgid % nig) / gsz; return true;
    }
    __device__ __forceinline__ void a_ready(const Unit&) const {}
    __device__ __forceinline__ void done(const Unit&) const {}
};
typedef int i32x8 __attribute__((ext_vector_type(8)));
__device__ __forceinline__ i32x8 ld8(const PG8_LAS unsigned char* p) { typedef int i32x4 __attribute__((ext_vector_type(4))); const i32x4 a = *(const PG8_LAS i32x4*)p, b = *(const PG8_LAS i32x4*)(p + 1024); return __builtin_shufflevector(a, b, 0, 1, 2, 3, 4, 5, 6, 7); }
__device__ __forceinline__ i32x8 cat8(bf16x8 lo, bf16x8 hi) { typedef int i32x4 __attribute__((ext_vector_type(4))); const i32x4 a = __builtin_bit_cast(i32x4, lo), b = __builtin_bit_cast(i32x4, hi); return (i32x8){a[0], a[1], a[2], a[3], b[0], b[1], b[2], b[3]}; }
template <class Epi, class Sched, bool ALIGN_EPI = false, bool SP2 = false, bool HALFCAP = false, bool FP8 = false, bool MIDHOOK = false, bool GATHER = false>
__device__ __forceinline__ void gemm_phase(PG8_LAS unsigned char* lds, const Gemm g, const Sched& S, const Epi& E) {
    const int tid = threadIdx.x, wid = __builtin_amdgcn_readfirstlane(tid >> 6), lane = tid & 63, wr = wid >> 2, wc = wid & 3, fr = lane & 15, fq = lane >> 4;
    const int K = FP8 ? g.K / 2 : g.K, nt = K / BK;
    unsigned voffA[2], voffB[2];
#pragma unroll
    for (int i = 0; i < 2; ++i) { int R, C; stage_rc(tid * 16 + i * 8192, R, C); const int Rb = Epi::PERM ? ((R & ~31) + perm32(R & 31)) : R;
        voffA[i] = (unsigned)(R * K + C) * 2u; voffB[i] = (unsigned)(Rb * K + C) * 2u; }
    const size_t kstep = (size_t)(BK * 2);
    const size_t hstep = (size_t)HALF * K * 2;
    const size_t tstep = 2 * hstep;
    const unsigned ldsw = (unsigned)wid * 1024u;
    const int aoff = lds_byte(wr * 64 + fr, fq * 8), boff = lds_byte(wc * 32 + fr, fq * 8);
#define PG8_SA(b, h) (((b) * 2 + (h)) * HTB)
#define PG8_SB(b, h) ((4 + (b) * 2 + (h)) * HTB)
#define PG8_STAGE(bufoff, gbase, voff) do { _Pragma("unroll") for (int _i = 0; _i < 2; ++_i) \
        __builtin_amdgcn_global_load_lds((const unsigned*)((const char*)(gbase) + (voff)[_i]), (PG8_LAS unsigned*)(lds + (bufoff) + ldsw + _i * 8192), 16, 0, 0); } while (0)
#define PG8_LDA(dst, b, h) do { if constexpr (FP8) { _Pragma("unroll") for (int m = 0; m < 4; ++m) dst##8[m] = ld8(lds + PG8_SA(b, h) + aoff + m * 2048); } else { _Pragma("unroll") for (int m = 0; m < 4; ++m) _Pragma("unroll") for (int k = 0; k < 2; ++k) dst[m][k] = *(const PG8_LAS bf16x8*)(lds + PG8_SA(b, h) + aoff + m * 2048 + k * 1024); } } while (0)
#define PG8_LDB(dst, b, h) do { if constexpr (FP8) { _Pragma("unroll") for (int n = 0; n < 2; ++n) dst##8[n] = ld8(lds + PG8_SB(b, h) + boff + n * 2048); } else { _Pragma("unroll") for (int n = 0; n < 2; ++n) _Pragma("unroll") for (int k = 0; k < 2; ++k) dst[n][k] = *(const PG8_LAS bf16x8*)(lds + PG8_SB(b, h) + boff + n * 2048 + k * 1024); } } while (0)
#define PG8_MMA(ai, bj, At, Bt) do { __builtin_amdgcn_s_setprio(1); _Pragma("unroll") for (int m = 0; m < 4; ++m) _Pragma("unroll") for (int n = 0; n < 2; ++n) { \
        if constexpr (FP8) { asm volatile("v_mfma_scale_f32_16x16x128_f8f6f4 %0, %1, %2, %0, %3, %3 op_sel_hi:[0,0,0]" : "+v"(acc[ai][bj][m][n]) : "v"(Bt##8[n]), "v"(At##8[m]), "v"(sc_one)); } \
        else { _Pragma("unroll") for (int k = 0; k < 2; ++k) acc[ai][bj][m][n] = __builtin_amdgcn_mfma_f32_16x16x32_bf16(Bt[n][k], At[m][k], acc[ai][bj][m][n], 0, 0, 0); } } __builtin_amdgcn_s_setprio(0); } while (0)
#define PG8_WAIT_V(n) asm volatile("s_waitcnt vmcnt(" #n ")" ::: "memory")
#define PG8_WAIT_L(n) asm volatile("s_waitcnt lgkmcnt(" #n ")" ::: "memory")
#define PG8_BAR __builtin_amdgcn_s_barrier()
#define PG8_SCHED __builtin_amdgcn_sched_barrier(0)
    Unit cur, nxt; int ui = 0;
    if (!S.next(0, cur)) return;
    f32x4 acc[2][2][4][2];
#pragma unroll
    for (int a = 0; a < 2; ++a)
#pragma unroll
        for (int b = 0; b < 2; ++b)
#pragma unroll
            for (int m = 0; m < 4; ++m)
#pragma unroll
                for (int n = 0; n < 2; ++n) acc[a][b][m][n] = (f32x4){0.f, 0.f, 0.f, 0.f};
    bf16x8 At[4][2], B0[2][2], B1[2][2];
    i32x8 At8[4], B08[2], B18[2]; const int sc_one = 0x7f7f7f7f;
    const char* cA = (const char*)g.A + (size_t)cur.pm * tstep; const char* cB = (const char*)g.Bt + (size_t)cur.pn * tstep;
    S.a_ready(cur);
    unsigned cof[2][2] = {{0u, 0u}, {0u, 0u}}, nof[2][2] = {{0u, 0u}, {0u, 0u}}; int gR[2] = {0, 0}; unsigned gC[2] = {0u, 0u};
    if constexpr (GATHER) {
#pragma unroll
        for (int i = 0; i < 2; ++i) { int R, C; stage_rc(tid * 16 + i * 8192, R, C); gR[i] = R; gC[i] = (unsigned)C * 2u; }
#pragma unroll
        for (int h = 0; h < 2; ++h)
#pragma unroll
            for (int i = 0; i < 2; ++i) cof[h][i] = (unsigned)S.row_of(0, h * HALF + gR[i]) * (unsigned)(2 * K) + gC[i];
    }
#define PG8_STAGE_GA(bufoff, h, use_next, kb) do { const unsigned _o0 = (use_next) ? nof[h][0] : cof[h][0], _o1 = (use_next) ? nof[h][1] : cof[h][1]; const char* _gb = (const char*)g.A + (kb); \
        __builtin_amdgcn_global_load_lds((const unsigned*)(_gb + _o0), (PG8_LAS unsigned*)(lds + (bufoff) + ldsw), 16, 0, 0); \
        __builtin_amdgcn_global_load_lds((const unsigned*)(_gb + _o1), (PG8_LAS unsigned*)(lds + (bufoff) + ldsw + 8192), 16, 0, 0); } while (0)
    if constexpr (SP2) {
        PG8_STAGE(PG8_SB(0, 0), cB, voffB); PG8_STAGE(PG8_SB(0, 1), cB + hstep, voffB);
        if constexpr (GATHER) { PG8_STAGE_GA(PG8_SA(0, 0), 0, false, 0); PG8_STAGE_GA(PG8_SA(0, 1), 1, false, 0); } else { PG8_STAGE(PG8_SA(0, 0), cA, voffA); PG8_STAGE(PG8_SA(0, 1), cA + hstep, voffA); }
        if (wr == 1) PG8_BAR;
        PG8_WAIT_V(2); PG8_BAR;
        PG8_STAGE(PG8_SB(1, 0), cB + kstep, voffB); if constexpr (GATHER) PG8_STAGE_GA(PG8_SA(1, 0), 0, false, kstep); else PG8_STAGE(PG8_SA(1, 0), cA + kstep, voffA); PG8_STAGE(PG8_SB(1, 1), cB + hstep + kstep, voffB);
        PG8_WAIT_V(6); PG8_BAR;
    } else {
        PG8_STAGE(PG8_SB(0, 0), cB, voffB); PG8_STAGE(PG8_SA(0, 0), cA, voffA); PG8_STAGE(PG8_SB(0, 1), cB + hstep, voffB); PG8_STAGE(PG8_SA(0, 1), cA + hstep, voffA);
        if (wr == 1) PG8_BAR;
        PG8_WAIT_V(4); PG8_BAR;
        PG8_STAGE(PG8_SB(1, 0), cB + kstep, voffB); PG8_STAGE(PG8_SA(1, 0), cA + kstep, voffA); PG8_STAGE(PG8_SB(1, 1), cB + hstep + kstep, voffB);
        PG8_WAIT_V(6); PG8_BAR;
    }
    for (;;) {
        const bool has_next = S.next(ui + 1, nxt);
        const char* nA = has_next ? (const char*)g.A + (size_t)nxt.pm * tstep : cA; const char* nB = has_next ? (const char*)g.Bt + (size_t)nxt.pn * tstep : cB;
        const bool half = HALFCAP && cur.rm != 0;
        if constexpr (GATHER) {
#pragma unroll
            for (int h = 0; h < 2; ++h)
#pragma unroll
                for (int i = 0; i < 2; ++i) nof[h][i] = has_next ? (unsigned)S.row_of(ui + 1, h * HALF + gR[i]) * (unsigned)(2 * K) + gC[i] : cof[h][i];
        }
        for (int t = 0; t < nt; t += 2) {
            const bool last = (t == nt - 2);
            const char* a1 = cA + (size_t)(t + 1) * kstep;
            const char* a2 = last ? nA : cA + (size_t)(t + 2) * kstep; const char* b2 = last ? nB : cB + (size_t)(t + 2) * kstep;
            const char* a3 = a2 + kstep; const char* b3 = b2 + kstep;
            if constexpr (MIDHOOK) { if (t == nt / 2) E.mid(acc, cur, wr, wc, fr, fq); }
            if (last && has_next) S.a_ready(nxt);
            if constexpr (SP2) {
            PG8_LDB(B0, 0, 0); PG8_LDB(B1, 0, 1); PG8_SCHED; PG8_LDA(At, 0, 0); if constexpr (GATHER) PG8_STAGE_GA(PG8_SA(1, 1), 1, false, (size_t)(t + 1) * kstep); else PG8_STAGE(PG8_SA(1, 1), a1 + hstep, voffA);
            PG8_WAIT_V(8); PG8_WAIT_L(0); PG8_BAR; PG8_MMA(0, 0, At, B0); PG8_MMA(0, 1, At, B1); PG8_BAR; PG8_SCHED;
            if (!half) PG8_LDA(At, 0, 1); PG8_STAGE(PG8_SB(0, 0), b2, voffB); PG8_STAGE(PG8_SB(0, 1), b2 + hstep, voffB); if constexpr (GATHER) PG8_STAGE_GA(PG8_SA(0, 0), 0, last, last ? (size_t)0 : (size_t)(t + 2) * kstep); else PG8_STAGE(PG8_SA(0, 0), a2, voffA);
            PG8_WAIT_V(8); PG8_WAIT_L(0); PG8_BAR; if (!half) { PG8_MMA(1, 0, At, B0); PG8_MMA(1, 1, At, B1); } PG8_BAR; PG8_SCHED;
            PG8_LDB(B0, 1, 0); PG8_LDB(B1, 1, 1); PG8_SCHED; PG8_LDA(At, 1, 0); if constexpr (GATHER) PG8_STAGE_GA(PG8_SA(0, 1), 1, last, last ? (size_t)0 : (size_t)(t + 2) * kstep); else PG8_STAGE(PG8_SA(0, 1), a2 + hstep, voffA);
            PG8_WAIT_V(8); PG8_WAIT_L(0); PG8_BAR; PG8_MMA(0, 0, At, B0); PG8_MMA(0, 1, At, B1); PG8_BAR; PG8_SCHED;
            if (!half) PG8_LDA(At, 1, 1); PG8_STAGE(PG8_SB(1, 0), b3, voffB); PG8_STAGE(PG8_SB(1, 1), b3 + hstep, voffB); if constexpr (GATHER) PG8_STAGE_GA(PG8_SA(1, 0), 0, last, last ? kstep : (size_t)(t + 3) * kstep); else PG8_STAGE(PG8_SA(1, 0), a3, voffA);
            PG8_WAIT_V(8); PG8_WAIT_L(0); PG8_BAR; if (!half) { PG8_MMA(1, 0, At, B0); PG8_MMA(1, 1, At, B1); } PG8_BAR; PG8_SCHED;
            } else {
            PG8_LDB(B0, 0, 0); PG8_SCHED; PG8_LDA(At, 0, 0); PG8_STAGE(PG8_SA(1, 1), a1 + hstep, voffA);
            PG8_WAIT_L(8); PG8_BAR; PG8_WAIT_L(0); PG8_MMA(0, 0, At, B0); PG8_BAR; PG8_SCHED;
            PG8_LDB(B1, 0, 1); PG8_STAGE(PG8_SB(0, 0), b2, voffB);
            PG8_BAR; PG8_WAIT_L(0); PG8_MMA(0, 1, At, B1); PG8_BAR;
            PG8_LDA(At, 0, 1); PG8_STAGE(PG8_SA(0, 0), a2, voffA);
            PG8_BAR; PG8_WAIT_L(0); PG8_MMA(1, 0, At, B0); PG8_BAR; PG8_SCHED;
            PG8_STAGE(PG8_SB(0, 1), b2 + hstep, voffB);
            PG8_WAIT_V(6); PG8_BAR; PG8_MMA(1, 1, At, B1); PG8_BAR;
            PG8_LDB(B0, 1, 0); PG8_SCHED; PG8_LDA(At, 1, 0); PG8_STAGE(PG8_SA(0, 1), a2 + hstep, voffA);
            PG8_WAIT_L(8); PG8_BAR; PG8_WAIT_L(0); PG8_MMA(0, 0, At, B0); PG8_BAR; PG8_SCHED;
            PG8_LDB(B1, 1, 1); PG8_STAGE(PG8_SB(1, 0), b3, voffB);
            PG8_BAR; PG8_WAIT_L(0); PG8_MMA(0, 1, At, B1); PG8_BAR;
            PG8_LDA(At, 1, 1); PG8_STAGE(PG8_SA(1, 0), a3, voffA);
            PG8_BAR; PG8_WAIT_L(0); PG8_MMA(1, 0, At, B0); PG8_BAR; PG8_SCHED;
            PG8_STAGE(PG8_SB(1, 1), b3 + hstep, voffB);
            PG8_WAIT_V(6); PG8_BAR; PG8_MMA(1, 1, At, B1); PG8_BAR;
            }
        }
        if constexpr (FP8) asm volatile("s_nop 15\n\ts_nop 15" ::: "memory");
        if constexpr (ALIGN_EPI) { if (wr == 0) PG8_BAR; }
        if constexpr (!Epi::AFTER_DRAIN) { E(acc, cur, wr, wc, fr, fq); S.done(cur); }
        if (!has_next) break;
#pragma unroll
        for (int a = 0; a < 2; ++a)
#pragma unroll
            for (int b = 0; b < 2; ++b)
#pragma unroll
                for (int m = 0; m < 4; ++m)
#pragma unroll
                    for (int n = 0; n < 2; ++n) acc[a][b][m][n] = (f32x4){0.f, 0.f, 0.f, 0.f};
        cur = nxt; cA = nA; cB = nB; ++ui;
        if constexpr (GATHER) { cof[0][0] = nof[0][0]; cof[0][1] = nof[0][1]; cof[1][0] = nof[1][0]; cof[1][1] = nof[1][1]; }
        if constexpr (ALIGN_EPI) { if (wr == 1) PG8_BAR; }
    }
    PG8_WAIT_V(0);
    if constexpr (!ALIGN_EPI) { if (wr == 0) PG8_BAR; }
    PG8_BAR;
    if constexpr (Epi::AFTER_DRAIN) { E.fused(acc, cur, wr, wc, fr, fq, lds, wid, lane); S.done(cur); }
#undef PG8_SA
#undef PG8_SB
#undef PG8_STAGE
#undef PG8_STAGE_GA
#undef PG8_LDA
#undef PG8_LDB
#undef PG8_MMA
#undef PG8_WAIT_V
#undef PG8_WAIT_L
#undef PG8_BAR
#undef PG8_SCHED
}
}

constexpr int NB = 2, SEQ = 4096, T = NB * SEQ, D = 2048, NIN = 8448;
constexpr int C_QA = 0, C_KA = 1024, C_VA = 1152, C_QB = 1280, C_KB = 2304, C_VB = 3328, C_GA = 4352, C_GB = 6400;
constexpr int NE = 32, FF = 2048, MEMLEN = 256;
constexpr int RMAX = 32768 + NE * 256;
constexpr float ALPHA = 1.18920711500272f;
constexpr float LN_EPS = 1e-5f;
constexpr int NWAVES = 8;
#ifndef MK_ONE_LAUNCH
#define MK_ONE_LAUNCH 1
#endif
constexpr int NPHASE = 14;

constexpr size_t MiB = 1u << 20;
constexpr size_t WS_CTL = 0, CTL_ZERO_BYTES = 65536;
constexpr size_t WS_TAB = 1 * MiB;
constexpr size_t WS_ROUTE = 2 * MiB;
constexpr size_t WS_BT1 = 4 * MiB;
constexpr size_t WS_BTAB = 54 * MiB;
constexpr size_t WS_BTMIX = 62 * MiB, WS_BTXQ = 70 * MiB, WS_BTXO = 78 * MiB;
constexpr size_t WS_BTUP = 88 * MiB;
constexpr size_t WS_BTDN = 600 * MiB;
constexpr size_t WS_H0F = 856 * MiB;
constexpr size_t WS_H0B = 920 * MiB;
constexpr size_t WS_PROJ = 954 * MiB;
constexpr size_t WS_KMEM = 1086 * MiB;
constexpr size_t WS_VT = 1088 * MiB;
constexpr size_t WS_OAB = 1090 * MiB;
constexpr size_t WS_G1 = 1122 * MiB;
constexpr size_t WS_GG = 1186 * MiB;
constexpr size_t WS_S1 = 1218 * MiB;
constexpr size_t WS_H1F = 1282 * MiB, WS_H1B = 1346 * MiB, WS_QX = 1378 * MiB, WS_OX = 1410 * MiB, WS_H2F = 1442 * MiB, WS_H2B = 1506 * MiB;
constexpr size_t WS_XS = 1538 * MiB, WS_ACT = 1698 * MiB, WS_YR = 1858 * MiB, WS_END = 2018 * MiB;
static_assert(WS_BT1 + (size_t)12544 * 2048 * 2 <= WS_BTAB && WS_H0B + (size_t)8704 * 2048 * 2 <= WS_PROJ && WS_PROJ + (size_t)T * NIN * 2 <= WS_KMEM && WS_XS + (size_t)RMAX * 2048 * 2 <= WS_ACT, "ws map");

constexpr int CW_TMO = 0, CW_CODE = 1;
constexpr int CW_CNT = 1024;
constexpr int CW_SUB = 3584;
constexpr int CW_BAR = 4096;

constexpr int RING_OFF = 0, RING_BYTES = 131072;
constexpr int LDSCTL_OFF = RING_BYTES, MISC_OFF = LDSCTL_OFF + 320;
constexpr int LDS_BYTES = 147456;

#define GAS __attribute__((address_space(1)))
#define LAS __attribute__((address_space(3)))
typedef unsigned short bf16;
typedef unsigned v4u __attribute__((ext_vector_type(4)));
typedef unsigned v2u __attribute__((ext_vector_type(2)));
typedef float f32x4 __attribute__((ext_vector_type(4)));
typedef GAS unsigned gu32;
#define RLX_AGENT __ATOMIC_RELAXED, __HIP_MEMORY_SCOPE_AGENT
#define LDS_WAIT() asm volatile("s_waitcnt lgkmcnt(0)" ::: "memory")
#define VM_WAIT() asm volatile("s_waitcnt vmcnt(0)" ::: "memory")
typedef float f32x2_ __attribute__((ext_vector_type(2)));
typedef __bf16 bf16x2_ __attribute__((ext_vector_type(2)));
__device__ __forceinline__ unsigned pk2(float lo, float hi) { const f32x2_ v = {lo, hi}; const bf16x2_ b = __builtin_convertvector(v, bf16x2_); return __builtin_bit_cast(unsigned, b); }
__device__ __forceinline__ float bflo(unsigned w) { return __uint_as_float(w << 16); }
__device__ __forceinline__ float bfhi(unsigned w) { return __uint_as_float(w & 0xffff0000u); }
__device__ __forceinline__ float sigmoidf_(float x) { return __builtin_amdgcn_rcpf(1.0f + __expf(-x)); }
__device__ __forceinline__ float wave_sum(float v) {
#pragma unroll
    for (int o = 1; o < 64; o <<= 1) v += __shfl_xor(v, o);
    return v;
}
__device__ __forceinline__ unsigned pk4_fp8(float a, float b, float c, float d) { int w = __builtin_amdgcn_cvt_pk_fp8_f32(a, b, 0, false); w = __builtin_amdgcn_cvt_pk_fp8_f32(c, d, w, true); return (unsigned)w; }
constexpr float W8_SCALE = 64.0f, W8_INV = 1.0f / 64.0f;
#define XB_TMO      128
#define XB_XCNT(j)  (256  + 64 * (j))
#define XB_XSUB(j)  (1280 + 64 * (j))
#define XB_XGEN(j)  (2304 + 64 * (j))
#define XB_TOP      3328
#define XB_TOPGEN   3392
#define XCD_BAR_WORDS 3456
#define XB_SPIN_CAP (1u << 18)

__device__ __forceinline__ unsigned xb_ld(unsigned* p)              { return __hip_atomic_load(p, __ATOMIC_RELAXED, __HIP_MEMORY_SCOPE_AGENT); }
__device__ __forceinline__ unsigned xb_add(unsigned* p, unsigned v) { return __hip_atomic_fetch_add(p, v, __ATOMIC_RELAXED, __HIP_MEMORY_SCOPE_AGENT); }
__device__ __forceinline__ unsigned xb_xcc_id() { return (unsigned)__builtin_amdgcn_s_getreg((3 << 11) | 20) & 0xFu; }
#define XB_SPIN(cond, bar) do { unsigned _sp = 0; while (cond) { __builtin_amdgcn_s_sleep(1); \
    if ((++_sp & 255u) == 0u) { if (xb_ld(&(bar)[XB_TMO])) break; if (_sp > XB_SPIN_CAP) { atomicAdd(&(bar)[XB_TMO], 1u); break; } } } } while (0)

struct XcdBarrier {
    unsigned* bar; unsigned x;
    volatile LAS unsigned* st;
};

__device__ __forceinline__ XcdBarrier xcd_barrier_post(unsigned* bar, volatile LAS unsigned* st) {
    XcdBarrier b; b.bar = bar; b.x = xb_xcc_id(); b.st = st;
    if (threadIdx.x == 0) (void)xb_add(&bar[XB_XCNT(b.x)], 1u);
    return b;
}
__device__ __forceinline__ void xcd_barrier_complete(unsigned* bar, unsigned x, unsigned& nloc, unsigned& nx) {
    const unsigned G = gridDim.x * gridDim.y * gridDim.z;
    unsigned sum, cnt, mine, sp = 0u;
    for (;;) {
        sum = 0u; cnt = 0u; mine = 0u;
#pragma unroll
        for (unsigned j = 0; j < 16; ++j) { const unsigned c = xb_ld(&bar[XB_XCNT(j)]); sum += c; cnt += (c > 0u) ? 1u : 0u; mine = (j == x) ? c : mine; }
        if (sum == G) break;
        __builtin_amdgcn_s_sleep(1);
        if ((++sp & 255u) == 0u) { if (xb_ld(&bar[XB_TMO])) break; if (sp > XB_SPIN_CAP) { atomicAdd(&bar[XB_TMO], 1u); break; } }
    }
    nloc = mine > 0u ? mine : 1u; nx = cnt > 0u ? cnt : 1u;
}

__device__ __forceinline__ void xcd_barrier(const XcdBarrier& b) {
    asm volatile("s_waitcnt vmcnt(0)" ::: "memory");
    __syncthreads();
    if (threadIdx.x == 0) {
        unsigned* bar = b.bar;
        __builtin_amdgcn_s_waitcnt(0);
        unsigned nloc = b.st[0], nx = b.st[1];
        if (nloc == 0u) { xcd_barrier_complete(bar, b.x, nloc, nx); b.st[0] = nloc; b.st[1] = nx; }
        const unsigned old = xb_add(&bar[XB_XSUB(b.x)], 1u);
        const unsigned gen = old / nloc;
        if (old + 1u == (gen + 1u) * nloc) {
            __builtin_amdgcn_fence(__ATOMIC_RELEASE, "agent");
            asm volatile("s_waitcnt vmcnt(0)" ::: "memory");
            const unsigned og = xb_add(&bar[XB_TOP], 1u);
            const unsigned tg = og / nx;
            if (og + 1u == (tg + 1u) * nx) xb_add(&bar[XB_TOPGEN], 1u);
            else XB_SPIN(xb_ld(&bar[XB_TOPGEN]) == tg, bar);
            __builtin_amdgcn_fence(__ATOMIC_ACQUIRE, "agent");
            xb_add(&bar[XB_XGEN(b.x)], 1u);
            asm volatile("s_waitcnt vmcnt(0)" ::: "memory");
        } else {
            XB_SPIN(xb_ld(&bar[XB_XGEN(b.x)]) == gen, bar);
            __builtin_amdgcn_fence(__ATOMIC_ACQUIRE, "agent");
            asm volatile("s_waitcnt vmcnt(0)" ::: "memory");
        }
    }
    __syncthreads();
}

namespace blk {
using pg8::Unit; using pg8::f32x4; using pg8::u32x4; using pg8::bf16_t;
typedef float f32x4_t __attribute__((ext_vector_type(4)));

struct SchedP1 {
    pg8::StaticOrder so;
    __device__ __forceinline__ void init(int G, int c) { so.init(T, NIN, G, c); }
    __device__ __forceinline__ bool next(int i, Unit& u) const {
        const long L = (long)i * so.G + so.c;
        constexpr int MA = (int)(WS_H0B / MiB), MB = (int)(WS_BT1 / MiB);
        if (L < so.nwg) { if (!so.next(i, u)) return false; u.rm = u.pm; u.rn = u.pn; u.pm += MA; u.pn += MB; return true; }
        const int j = (int)(L - so.nwg); if (j >= 32) return false;
        if (j < 16) { const int mb = j & 1, ct = j >> 1; u.pm = MA + 32 + mb; u.pn = MB + 33 + ct; u.rm = mb; u.rn = 64 + ct; }
        else { const int jj = j - 16, dt = jj >> 1, mb = jj & 1; u.pm = MB + 33 + 8 + dt; u.pn = MA + 32 + mb; u.rm = dt; u.rn = 128 + mb; }
        return true;
    }
    __device__ __forceinline__ void a_ready(const Unit&) const {}
    __device__ __forceinline__ void done(const Unit&) const {}
};
struct EpiProj {
    static constexpr bool PERM = true, AFTER_DRAIN = false;
    unsigned char* ws; const float* bias;
    __device__ __forceinline__ void operator()(const f32x4 (&acc)[2][2][4][2], const Unit& u, int wr, int wc, int fr, int fq) const {
        const int kind = u.rn >> 6; const bool mn = kind == 0;
        bf16_t* base = (bf16_t*)(ws + WS_PROJ + (size_t)(kind >= 1) * (WS_KMEM - WS_PROJ) + (size_t)(kind >= 2) * (WS_VT - WS_KMEM)); const int ldc = 512 + (kind <= 1) * 1536 + (kind == 0) * (NIN - 2048);
        const int row0 = u.rm * 256 + wr * 64 + fr, col0 = (u.rn & 63) * 256 + wc * 32 + 8 * fq;
        f32x4 bv[2][2];
#pragma unroll
        for (int bj = 0; bj < 2; ++bj)
#pragma unroll
            for (int n = 0; n < 2; ++n) bv[bj][n] = mn ? *(const f32x4*)(bias + col0 + bj * 128 + 4 * n) : (f32x4){0.f, 0.f, 0.f, 0.f};
#pragma unroll
        for (int ai = 0; ai < 2; ++ai)
#pragma unroll
            for (int m = 0; m < 4; ++m) { bf16_t* rowp = base + (size_t)(row0 + ai * 128 + m * 16) * ldc + col0;
#pragma unroll
                for (int bj = 0; bj < 2; ++bj) { const f32x4 v0 = acc[ai][bj][m][0] + bv[bj][0], v1 = acc[ai][bj][m][1] + bv[bj][1];
                    u32x4 w; w.x = pk2(v0[0], v0[1]); w.y = pk2(v0[2], v0[3]); w.z = pk2(v1[0], v1[1]); w.w = pk2(v1[2], v1[3]);
                    *(u32x4*)(rowp + bj * 128) = w; } }
    }
};
struct EpiBf16B {
    static constexpr bool PERM = true, AFTER_DRAIN = false;
    bf16_t* O; int ldc; const float* bias; int cmask, cshift, bstride; float scale;
    __device__ __forceinline__ void operator()(const f32x4 (&acc)[2][2][4][2], const Unit& u, int wr, int wc, int fr, int fq) const {
        const int row0 = u.pm * 256 + wr * 64 + fr, col0 = (u.pn & cmask) * 256 + wc * 32 + 8 * fq;
        const float* bp = bias ? bias + (size_t)(u.pn >> cshift) * bstride + col0 : nullptr;
        f32x4 bv[2][2];
#pragma unroll
        for (int bj = 0; bj < 2; ++bj)
#pragma unroll
            for (int n = 0; n < 2; ++n) bv[bj][n] = bp ? *(const f32x4*)(bp + bj * 128 + 4 * n) : (f32x4){0.f, 0.f, 0.f, 0.f};
#pragma unroll
        for (int ai = 0; ai < 2; ++ai)
#pragma unroll
            for (int m = 0; m < 4; ++m) { bf16_t* rowp = O + (size_t)(row0 + ai * 128 + m * 16) * ldc + col0;
#pragma unroll
                for (int bj = 0; bj < 2; ++bj) { const f32x4 v0 = acc[ai][bj][m][0] * scale + bv[bj][0], v1 = acc[ai][bj][m][1] * scale + bv[bj][1];
                    u32x4 w; w.x = pk2(v0[0], v0[1]); w.y = pk2(v0[2], v0[3]); w.z = pk2(v1[0], v1[1]); w.w = pk2(v1[2], v1[3]);
                    *(u32x4*)(rowp + bj * 128) = w; } }
    }
};
struct EpiGate {
    static constexpr bool PERM = true, AFTER_DRAIN = false;
    const bf16_t* proj; bf16_t* gg;
    __device__ __forceinline__ static float em(float x) { return __expf(-x); }
    __device__ __forceinline__ void mid(f32x4 (&acc)[2][2][4][2], const Unit& u, int wr, int wc, int fr, int fq) const {
        int row0 = u.pm * 256 + wr * 64 + fr; const int col0 = u.pn * 256 + wc * 32 + 8 * fq;
        asm volatile("" : "+v"(row0));
#pragma unroll
        for (int ai = 0; ai < 2; ++ai)
#pragma unroll
            for (int m = 0; m < 4; ++m) { const size_t row = (size_t)(row0 + ai * 128 + m * 16);
#pragma unroll
                for (int bj = 0; bj < 2; ++bj) {
                    const u32x4 ga = *(const u32x4*)(proj + row * NIN + C_GA + col0 + bj * 128), gb = *(const u32x4*)(proj + row * NIN + C_GB + col0 + bj * 128);
                    const unsigned gaw[4] = {ga.x, ga.y, ga.z, ga.w}, gbw[4] = {gb.x, gb.y, gb.z, gb.w};
#pragma unroll
                    for (int q = 0; q < 4; ++q) {
                        const float r0 = (1.0f + em(fmaxf(bflo(gbw[q]), -60.0f))) * __builtin_amdgcn_rcpf(1.0f + em(bflo(gaw[q]))), r1 = (1.0f + em(fmaxf(bfhi(gbw[q]), -60.0f))) * __builtin_amdgcn_rcpf(1.0f + em(bfhi(gaw[q])));
                        acc[ai][bj][m][q >> 1][2 * (q & 1)] *= r0; acc[ai][bj][m][q >> 1][2 * (q & 1) + 1] *= r1; } }
                asm volatile("" ::: "memory"); }
    }
    __device__ __forceinline__ void operator()(const f32x4 (&acc)[2][2][4][2], const Unit& u, int wr, int wc, int fr, int fq) const {
        int row0 = u.pm * 256 + wr * 64 + fr; const int col0 = u.pn * 256 + wc * 32 + 8 * fq;
        asm volatile("" : "+v"(row0));
#pragma unroll
        for (int ai = 0; ai < 2; ++ai)
#pragma unroll
            for (int m = 0; m < 4; ++m) { const size_t row = (size_t)(row0 + ai * 128 + m * 16);
#pragma unroll
                for (int bj = 0; bj < 2; ++bj) {
                    const u32x4 gb = *(const u32x4*)(proj + row * NIN + C_GB + col0 + bj * 128);
                    const unsigned gbw[4] = {gb.x, gb.y, gb.z, gb.w}; float o[8];
#pragma unroll
                    for (int q = 0; q < 4; ++q) { o[2 * q] = acc[ai][bj][m][q >> 1][2 * (q & 1)] * __builtin_amdgcn_rcpf(1.0f + em(fmaxf(bflo(gbw[q]), -60.0f))); o[2 * q + 1] = acc[ai][bj][m][q >> 1][2 * (q & 1) + 1] * __builtin_amdgcn_rcpf(1.0f + em(fmaxf(bfhi(gbw[q]), -60.0f))); }
                    u32x4 w; w.x = pk2(o[0], o[1]); w.y = pk2(o[2], o[3]); w.z = pk2(o[4], o[5]); w.w = pk2(o[6], o[7]);
                    *(u32x4*)(gg + row * D + col0 + bj * 128) = w; } }
    }
};
struct EpiRes {
    static constexpr bool PERM = false, AFTER_DRAIN = false;
    const float* res; float* out;
    __device__ __forceinline__ void operator()(const f32x4 (&acc)[2][2][4][2], const Unit& u, int wr, int wc, int fr, int fq) const {
        const int row0 = u.pm * 256 + wr * 64 + fr, col0 = u.pn * 256 + wc * 32 + 4 * fq;
#pragma unroll
        for (int ai = 0; ai < 2; ++ai)
#pragma unroll
            for (int m = 0; m < 4; ++m) { const size_t off = (size_t)(row0 + ai * 128 + m * 16) * D + col0;
#pragma unroll
                for (int bj = 0; bj < 2; ++bj)
#pragma unroll
                    for (int n = 0; n < 2; ++n) { const f32x4 r = *(const f32x4*)(res + off + bj * 128 + n * 16);
                        *(f32x4*)(out + off + bj * 128 + n * 16) = r * ALPHA + acc[ai][bj][m][n]; } }
    }
};
struct SchedMoE {
    static constexpr int RT_LDS = 12;
    const PG8_LAS int* mine; const PG8_LAS int* rts; const int* rowtok; int n;
    __device__ __forceinline__ void init(const int* tab, int nN, int G, int c, PG8_LAS int* lds_list, int tid, const int* rowtok_ = nullptr) {
        const int nwg = tab[192] * nN; const int* ul = tab + (nN == 16 ? 1024 : 8192);
        n = c < nwg ? (nwg - c + G - 1) / G : 0;
        if (tid < n && tid < 256) lds_list[tid] = ul[tid * G + c];
        rowtok = rowtok_; PG8_LAS int* r = lds_list + 256;
        if (rowtok_) { for (int i = 0; i < n && i < RT_LDS; ++i) { const int pm = ul[i * G + c] & 0xffff; if (tid < 256) r[i * 256 + tid] = rowtok_[pm * 256 + tid]; } }
        __syncthreads();
        mine = lds_list; rts = r;
    }
    __device__ __forceinline__ bool next(int i, Unit& u) const {
        if (i >= n) return false;
        const int x = mine[i]; u.pm = x & 0xffff; u.pn = x >> 16; u.rm = 0; u.rn = 0; return true;
    }
    __device__ __forceinline__ int row_of(int i, int r) const { return i < RT_LDS ? rts[i * 256 + r] : rowtok[(mine[i] & 0xffff) * 256 + r]; }
    __device__ __forceinline__ void a_ready(const Unit&) const {}
    __device__ __forceinline__ void done(const Unit&) const {}
};
struct EpiSwiGLU {
    static constexpr bool PERM = true, AFTER_DRAIN = false;
    unsigned char* act; const float* b_up;
    __device__ __forceinline__ void operator()(const f32x4 (&acc)[2][2][4][2], const Unit& u, int wr, int wc, int fr, int fq) const {
        const int e = u.pn >> 4, ct = u.pn & 15;
        const int row0 = u.pm * 256 + wr * 64 + fr, c8 = ct * 128 + wc * 32 + 8 * fq;
        f32x4 bg[2], bl[2];
#pragma unroll
        for (int n = 0; n < 2; ++n) { bg[n] = *(const f32x4*)(b_up + (size_t)e * 4096 + c8 + 4 * n); bl[n] = *(const f32x4*)(b_up + (size_t)e * 4096 + 2048 + c8 + 4 * n); }
#pragma unroll
        for (int ai = 0; ai < 2; ++ai)
#pragma unroll
            for (int m = 0; m < 4; ++m) { unsigned char* rowp = act + (size_t)(row0 + ai * 128 + m * 16) * FF + c8;
                float a[8];
#pragma unroll
                for (int n = 0; n < 2; ++n) { const f32x4 g = acc[ai][0][m][n] * W8_INV + bg[n], l = acc[ai][1][m][n] * W8_INV + bl[n];
#pragma unroll
                    for (int j = 0; j < 4; ++j) { const float gl = fminf(g[j], 7.0f), li = fminf(fmaxf(l[j], -7.0f), 7.0f);
                        a[4 * n + j] = gl * sigmoidf_(1.702f * gl) * (li + 1.0f); } }
                v2u w; w.x = pk4_fp8(a[0], a[1], a[2], a[3]); w.y = pk4_fp8(a[4], a[5], a[6], a[7]);
                *(v2u*)rowp = w; }
    }
};
}

struct Frame {
    LAS unsigned char* lds;
    volatile LAS unsigned* MISC;
    gu32* ctl;
    int tid, lane, wave, vcu, G;
    const float* const* in; float* out; unsigned char* ws;
};
#define WSP(type, off) ((type*)(F.ws + (off)))

#ifndef CVT_HASH
#define CVT_HASH 0
#endif
struct CvtMat { const float* W; void* WT; int K, N, drow_base, upperm, total, pitch, koff; };
constexpr int CVT_LP16 = 4;
constexpr int CVT_LP8 = 3;
template <bool FP8> __device__ __forceinline__ void cvt_addr(const CvtMat& M, int it_, const float*& src, unsigned char*& dst) {
    int it = it_;
    constexpr int LP = FP8 ? CVT_LP8 : CVT_LP16, KTS = 10 - LP, NTS = 2 + LP;
    if (FP8 && CVT_HASH) it = (int)(((unsigned)it * 40503u) & (unsigned)(M.total - 1));
    const int nblk = M.N >> NTS, per_e = (M.K >> KTS) * nblk, e = it / per_e, r = it - e * per_e, kb = r / nblk, nb = r - kb * nblk, n0 = nb << NTS;
    int drow = M.drow_base + n0;
    if (M.upperm) { const int half = n0 >= 2048 ? 1 : 0, nn = n0 - half * 2048; drow = (nn >> 7) * 256 + half * 128 + (nn & 127); }
    src = M.W + ((size_t)e * M.K + (kb << KTS)) * M.N + n0;
    dst = (unsigned char*)M.WT + (((size_t)e * M.N + drow) * M.pitch + M.koff + (kb << KTS)) * (FP8 ? 1 : 2);
}
__device__ __forceinline__ void tr_load(f32x4 (&v)[16], const float* src, int N, unsigned loff) {
    const unsigned long long base = (unsigned long long)src;
    const unsigned blo = __builtin_amdgcn_readfirstlane((unsigned)base), bhi = __builtin_amdgcn_readfirstlane((unsigned)(base >> 32));
    const unsigned long long ub = ((unsigned long long)bhi << 32) | blo; const unsigned long long rstep = (unsigned long long)(unsigned)N * 4ull;
#pragma unroll
    for (int i = 0; i < 16; ++i) { const unsigned long long rb = ub + (unsigned long long)i * rstep;
        asm volatile("global_load_dwordx4 %0, %1, %2 nt" : "=&v"(v[i]) : "v"(loff), "s"(rb) : "memory"); }
}
template <int NYOUNG> __device__ __forceinline__ void tr_wait(f32x4 (&v)[16]) {
    asm volatile("s_waitcnt vmcnt(%16)" : "+v"(v[0]), "+v"(v[1]), "+v"(v[2]), "+v"(v[3]), "+v"(v[4]), "+v"(v[5]), "+v"(v[6]), "+v"(v[7]), "+v"(v[8]), "+v"(v[9]), "+v"(v[10]), "+v"(v[11]), "+v"(v[12]), "+v"(v[13]), "+v"(v[14]), "+v"(v[15]) : "n"(NYOUNG) : "memory");
}
__device__ __forceinline__ void tr_store(const f32x4 (&v)[16], unsigned char* dst8, int K, int lane) {
    bf16* d0 = (bf16*)dst8 + (size_t)(4 * (lane & ((1 << CVT_LP16) - 1))) * K + 16 * (lane >> CVT_LP16);
#pragma unroll
    for (int j = 0; j < 4; ++j) {
        v4u lo, hi;
        lo.x = pk2(v[0][j], v[1][j]); lo.y = pk2(v[2][j], v[3][j]); lo.z = pk2(v[4][j], v[5][j]); lo.w = pk2(v[6][j], v[7][j]);
        hi.x = pk2(v[8][j], v[9][j]); hi.y = pk2(v[10][j], v[11][j]); hi.z = pk2(v[12][j], v[13][j]); hi.w = pk2(v[14][j], v[15][j]);
        bf16* d = d0 + (size_t)j * K;
        __builtin_nontemporal_store(lo, (v4u*)d); __builtin_nontemporal_store(hi, (v4u*)(d + 8));
    }
}
__device__ __forceinline__ void tr_store_fp8(const f32x4 (&v)[16], unsigned char* dst8, int K, int lane) {
    unsigned char* d0 = dst8 + (size_t)(4 * (lane & ((1 << CVT_LP8) - 1))) * K + 16 * (lane >> CVT_LP8);
#pragma unroll
    for (int j = 0; j < 4; ++j) {
        v4u o;
        o.x = pk4_fp8(v[0][j] * W8_SCALE, v[1][j] * W8_SCALE, v[2][j] * W8_SCALE, v[3][j] * W8_SCALE); o.y = pk4_fp8(v[4][j] * W8_SCALE, v[5][j] * W8_SCALE, v[6][j] * W8_SCALE, v[7][j] * W8_SCALE);
        o.z = pk4_fp8(v[8][j] * W8_SCALE, v[9][j] * W8_SCALE, v[10][j] * W8_SCALE, v[11][j] * W8_SCALE); o.w = pk4_fp8(v[12][j] * W8_SCALE, v[13][j] * W8_SCALE, v[14][j] * W8_SCALE, v[15][j] * W8_SCALE);
        __builtin_nontemporal_store(o, (v4u*)(d0 + (size_t)j * K));
    }
}
template <bool FP8> __device__ __forceinline__ void convert_mat(const CvtMat& M, int total, int wi, int nw, int lane) {
    constexpr int LP = FP8 ? CVT_LP8 : CVT_LP16;
    const unsigned loff = (unsigned)((16 * (lane >> LP)) * M.N + 4 * (lane & ((1 << LP) - 1))) * 4u;
    int it = wi;
    if constexpr (FP8) {
        for (; it + nw < total; it += 2 * nw) {
            const float* s0; const float* s1; unsigned char* d0; unsigned char* d1;
            cvt_addr<FP8>(M, it, s0, d0); cvt_addr<FP8>(M, it + nw, s1, d1);
            f32x4 v0[16], v1[16];
            tr_load(v0, s0, M.N, loff); tr_load(v1, s1, M.N, loff);
            tr_wait<16>(v0); tr_store_fp8(v0, d0, M.pitch, lane);
            tr_wait<0>(v1); tr_store_fp8(v1, d1, M.pitch, lane);
        }
    }
    if constexpr (!FP8)
    for (; it + 2 * nw < total; it += 3 * nw) {
        const float* s0; const float* s1; const float* s2; unsigned char* d0; unsigned char* d1; unsigned char* d2;
        cvt_addr<FP8>(M, it, s0, d0); cvt_addr<FP8>(M, it + nw, s1, d1); cvt_addr<FP8>(M, it + 2 * nw, s2, d2);
        f32x4 v0[16], v1[16], v2[16];
        tr_load(v0, s0, M.N, loff); tr_load(v1, s1, M.N, loff); tr_load(v2, s2, M.N, loff);
        tr_wait<32>(v0); if (FP8) tr_store_fp8(v0, d0, M.pitch, lane); else tr_store(v0, d0, M.pitch, lane);
        tr_wait<16>(v1); if (FP8) tr_store_fp8(v1, d1, M.pitch, lane); else tr_store(v1, d1, M.pitch, lane);
        tr_wait<0>(v2); if (FP8) tr_store_fp8(v2, d2, M.pitch, lane); else tr_store(v2, d2, M.pitch, lane);
    }
    for (; it < total; it += nw) {
        const float* s0; unsigned char* d0; cvt_addr<FP8>(M, it, s0, d0);
        f32x4 v0[16]; tr_load(v0, s0, M.N, loff); tr_wait<0>(v0); if (FP8) tr_store_fp8(v0, d0, M.pitch, lane); else tr_store(v0, d0, M.pitch, lane);
    }
}
__device__ __forceinline__ void ln_row(f32x4 (&v)[8], const float* g, const float* b, int lane) {
    float s = 0.f;
#pragma unroll
    for (int j = 0; j < 8; ++j) s += (v[j][0] + v[j][1]) + (v[j][2] + v[j][3]);
    const float mean = wave_sum(s) * (1.f / D);
    float s2 = 0.f;
#pragma unroll
    for (int j = 0; j < 8; ++j) { v[j] = v[j] - mean; s2 += (v[j][0] * v[j][0] + v[j][1] * v[j][1]) + (v[j][2] * v[j][2] + v[j][3] * v[j][3]); }
    const float rstd = 1.0f / sqrtf(wave_sum(s2) * (1.f / D) + LN_EPS);
#pragma unroll
    for (int j = 0; j < 8; ++j) { const f32x4 gg = ((const f32x4*)g)[lane + 64 * j], bb = ((const f32x4*)b)[lane + 64 * j]; v[j] = v[j] * rstd * gg + bb; }
}
__device__ __forceinline__ void row_load(f32x4 (&v)[8], const float* p, int lane) {
#pragma unroll
    for (int j = 0; j < 8; ++j) v[j] = ((const f32x4*)p)[lane + 64 * j];
}
__device__ __forceinline__ void row_store_f32(const f32x4 (&v)[8], float* p, int lane) {
#pragma unroll
    for (int j = 0; j < 8; ++j) ((f32x4*)p)[lane + 64 * j] = v[j];
}
__device__ __forceinline__ void row_store_bf16(const f32x4 (&v)[8], bf16* p, int lane) {
#pragma unroll
    for (int j = 0; j < 8; ++j) { v2u w; w.x = pk2(v[j][0], v[j][1]); w.y = pk2(v[j][2], v[j][3]); ((v2u*)p)[lane + 64 * j] = w; }
}

__device__ __forceinline__ void p0_prologue(Frame& F) {
    const int gw = F.vcu * NWAVES + F.wave, NGW = F.G * NWAVES;
    { const CvtMat M{F.in[5], WSP(bf16, WS_BT1), 2048, NIN, 0, 0, 32 * 132, 2048, 0}; convert_mat<false>(M, 32 * 132, gw, NGW, F.lane); }
    { const CvtMat M{F.in[14], WSP(bf16, WS_BT1), 2048, 4096, NIN, 0, 32 * 64, 2048, 0}; convert_mat<false>(M, 32 * 64, gw, NGW, F.lane); }
    for (int m = gw; m < T; m += NGW) {
        f32x4 v[8]; row_load(v, F.in[0] + (size_t)m * D, F.lane);
        ln_row(v, F.in[2], F.in[3], F.lane);
        row_store_f32(v, WSP(float, WS_H0F) + (size_t)m * D, F.lane);
        row_store_bf16(v, WSP(bf16, WS_H0B) + (size_t)m * D, F.lane);
    }
    for (int m = gw; m < NB * MEMLEN; m += NGW) {
        f32x4 v[8]; row_load(v, F.in[1] + (size_t)m * D, F.lane);
        row_store_bf16(v, WSP(bf16, WS_H0B) + (size_t)(T + m) * D, F.lane);
    }
}

__device__ __forceinline__ void cvt_role_p1(Frame& F, int wi, int nw) {
    { const CvtMat M{F.in[8], WSP(bf16, WS_BTAB), 1024, 2048, 0, 0, 16 * 32, 2048, 0}; convert_mat<false>(M, 16 * 32, wi, nw, F.lane); }
    { const CvtMat M{F.in[9], WSP(bf16, WS_BTAB), 1024, 2048, 0, 0, 16 * 32, 2048, 1024}; convert_mat<false>(M, 16 * 32, wi, nw, F.lane); }
    { const CvtMat M{F.in[10], WSP(bf16, WS_BTMIX), 2048, 2048, 0, 0, 32 * 32, 2048, 0}; convert_mat<false>(M, 32 * 32, wi, nw, F.lane); }
    { const CvtMat M{F.in[13], WSP(bf16, WS_BTXQ), 2048, 2048, 0, 0, 32 * 32, 2048, 0}; convert_mat<false>(M, 32 * 32, wi, nw, F.lane); }
    { const CvtMat M{F.in[15], WSP(bf16, WS_BTXO), 2048, 2048, 0, 0, 32 * 32, 2048, 0}; convert_mat<false>(M, 32 * 32, wi, nw, F.lane); }
    { const CvtMat M{F.in[20], WSP(bf16, WS_BTUP), 2048, 4096, 0, 1, NE * 32 * 64, 2048, 0}; convert_mat<true>(M, NE * 32 * 64, wi, nw, F.lane); }
    { const CvtMat M{F.in[22], WSP(bf16, WS_BTDN), 2048, 2048, 0, 0, NE * 32 * 32, 2048, 0}; convert_mat<true>(M, NE * 32 * 32, wi, nw, F.lane); }
}
__device__ __forceinline__ void cvt_role_p11(Frame& F, int wi, int nw) {
    const CvtMat M{F.in[22], WSP(bf16, WS_BTDN), 2048, 2048, 0, 0, NE * 32 * 32, 2048, 0}; convert_mat<true>(M, NE * 32 * 32, wi, nw, F.lane);
}
__device__ __forceinline__ int t5_bucket(int rel) {
    const int n = rel < 0 ? -rel : rel, base = rel > 0 ? 16 : 0;
    const int large = 8 + (n >= 12) + (n >= 16) + (n >= 23) + (n >= 32) + (n >= 46) + (n >= 64) + (n >= 91);
    return base + (n < 8 ? n : large);
}
__device__ __forceinline__ void load_row64(float (&q)[64], const bf16* p, float scale) {
#pragma unroll
    for (int i = 0; i < 8; ++i) { const v4u w = ((const v4u*)p)[i];
        q[8 * i + 0] = bflo(w.x) * scale; q[8 * i + 1] = bfhi(w.x) * scale; q[8 * i + 2] = bflo(w.y) * scale; q[8 * i + 3] = bfhi(w.y) * scale;
        q[8 * i + 4] = bflo(w.z) * scale; q[8 * i + 5] = bfhi(w.z) * scale; q[8 * i + 6] = bflo(w.w) * scale; q[8 * i + 7] = bfhi(w.w) * scale; }
}
__device__ __forceinline__ float dot_row64(const float (&q)[64], const bf16* p) {
    float s0 = 0.f, s1 = 0.f;
#pragma unroll
    for (int i = 0; i < 8; ++i) { const v4u w = ((const v4u*)p)[i];
        s0 += q[8 * i + 0] * bflo(w.x); s1 += q[8 * i + 1] * bfhi(w.x); s0 += q[8 * i + 2] * bflo(w.y); s1 += q[8 * i + 3] * bfhi(w.y);
        s0 += q[8 * i + 4] * bflo(w.z); s1 += q[8 * i + 5] * bfhi(w.z); s0 += q[8 * i + 6] * bflo(w.w); s1 += q[8 * i + 7] * bfhi(w.w); }
    return s0 + s1;
}
__device__ __forceinline__ void axpy_row64(float (&o)[64], float a, float p, const bf16* vp) {
#pragma unroll
    for (int i = 0; i < 8; ++i) { const v4u w = ((const v4u*)vp)[i];
        o[8 * i + 0] = o[8 * i + 0] * a + p * bflo(w.x); o[8 * i + 1] = o[8 * i + 1] * a + p * bfhi(w.x); o[8 * i + 2] = o[8 * i + 2] * a + p * bflo(w.y); o[8 * i + 3] = o[8 * i + 3] * a + p * bfhi(w.y);
        o[8 * i + 4] = o[8 * i + 4] * a + p * bflo(w.z); o[8 * i + 5] = o[8 * i + 5] * a + p * bfhi(w.z); o[8 * i + 6] = o[8 * i + 6] * a + p * bflo(w.w); o[8 * i + 7] = o[8 * i + 7] * a + p * bfhi(w.w); }
}
__device__ __forceinline__ void store_row64(const float (&o)[64], float scale, bf16* p) {
#pragma unroll
    for (int i = 0; i < 8; ++i) { v4u w; w.x = pk2(o[8 * i] * scale, o[8 * i + 1] * scale); w.y = pk2(o[8 * i + 2] * scale, o[8 * i + 3] * scale); w.z = pk2(o[8 * i + 4] * scale, o[8 * i + 5] * scale); w.w = pk2(o[8 * i + 6] * scale, o[8 * i + 7] * scale);
        ((v4u*)p)[i] = w; }
}
typedef short bf16x8 __attribute__((ext_vector_type(8)));
typedef float f32x16 __attribute__((ext_vector_type(16)));
#define MFMA32(a, b, c) __builtin_amdgcn_mfma_f32_32x32x16_bf16((a), (b), (c), 0, 0, 0)
__device__ __forceinline__ void p7_cross_mfma(Frame& F) {
    const bf16* qx = WSP(bf16, WS_QX); const bf16* kmem = WSP(bf16, WS_KMEM); const bf16* vT = WSP(bf16, WS_VT); bf16* ox = WSP(bf16, WS_OX);
    LAS unsigned char* L = F.lds + RING_OFF;
    constexpr int P_OFF = 0, P_STRIDE = 528, KV_OFF = 128 * P_STRIDE, K_STRIDE = 144, V_STRIDE = 528, ST_OFF = KV_OFF + 256 * K_STRIDE;
    static_assert(ST_OFF + 2048 <= RING_BYTES && 64 * V_STRIDE <= 256 * K_STRIDE, "cross-attention LDS map");
    const int w = F.wave, qt = w & 3, kh = w >> 2, r = F.lane & 31, h = F.lane >> 5, tid = F.tid;
    const float c2 = 0.044194173824159216f * 1.4426950408889634f;
    for (int u = F.vcu; u < 256; u += F.G) {
        const int b = u >> 7, head = (u >> 5) & 3, qblk = u & 31; const size_t row0 = (size_t)b * SEQ + qblk * 128;
        const bf16* qrow = qx + (row0 + qt * 32 + r) * D + head * 512 + 8 * h;
        const bf16* kbase = kmem + (size_t)b * MEMLEN * 2048 + head * 512;
        f32x16 sacc[4];
#pragma unroll
        for (int kt = 0; kt < 4; ++kt)
#pragma unroll
            for (int i = 0; i < 16; ++i) sacc[kt][i] = 0.f;
        v4u kst[4]; bf16x8 qf[4], qn[4];
#pragma unroll
        for (int j = 0; j < 4; ++j) { const int p = tid + 512 * j; kst[j] = *(const v4u*)(kbase + (size_t)(p >> 3) * 2048 + (p & 7) * 8); }
#pragma unroll
        for (int s = 0; s < 4; ++s) qf[s] = *(const bf16x8*)(qrow + 16 * s);
        for (int c = 0; c < 8; ++c) {
#pragma unroll
            for (int j = 0; j < 4; ++j) { const int p = tid + 512 * j; *(LAS v4u*)(L + KV_OFF + (p >> 3) * K_STRIDE + (p & 7) * 16) = kst[j]; }
            __syncthreads();
            if (c < 7) {
#pragma unroll
                for (int j = 0; j < 4; ++j) { const int p = tid + 512 * j; kst[j] = *(const v4u*)(kbase + (size_t)(p >> 3) * 2048 + (c + 1) * 64 + (p & 7) * 8); }
#pragma unroll
                for (int s = 0; s < 4; ++s) qn[s] = *(const bf16x8*)(qrow + (c + 1) * 64 + 16 * s);
            }
#pragma unroll
            for (int s = 0; s < 4; ++s)
#pragma unroll
                for (int kt = 0; kt < 4; ++kt) { const bf16x8 kf = *(const LAS bf16x8*)(L + KV_OFF + (kh * 128 + kt * 32 + r) * K_STRIDE + (16 * s + 8 * h) * 2);
                    sacc[kt] = MFMA32(kf, qf[s], sacc[kt]); }
            __syncthreads();
#pragma unroll
            for (int s = 0; s < 4; ++s) qf[s] = qn[s];
        }
        LAS float* mx = (LAS float*)(L + ST_OFF); LAS float* ls = mx + 256;
        float mloc = -3.0e38f;
#pragma unroll
        for (int kt = 0; kt < 4; ++kt)
#pragma unroll
            for (int i = 0; i < 16; ++i) mloc = fmaxf(mloc, sacc[kt][i]);
        mloc = fmaxf(mloc, __shfl_xor(mloc, 32));
        if (h == 0) mx[kh * 128 + qt * 32 + r] = mloc;
        __syncthreads();
        const float m = fmaxf(mx[qt * 32 + r], mx[128 + qt * 32 + r]);
        float lsum = 0.f;
#pragma unroll
        for (int kt = 0; kt < 4; ++kt)
#pragma unroll
            for (int i = 0; i < 16; ++i) { const float p = __builtin_amdgcn_exp2f((sacc[kt][i] - m) * c2); sacc[kt][i] = p; lsum += p; }
        lsum += __shfl_xor(lsum, 32);
        if (h == 0) ls[kh * 128 + qt * 32 + r] = lsum;
        __syncthreads();
        const float inv = 1.0f / (ls[qt * 32 + r] + ls[128 + qt * 32 + r]);
#pragma unroll
        for (int kt = 0; kt < 4; ++kt)
#pragma unroll
            for (int g = 0; g < 4; ++g) { v2u wv; wv.x = pk2(sacc[kt][4 * g] * inv, sacc[kt][4 * g + 1] * inv); wv.y = pk2(sacc[kt][4 * g + 2] * inv, sacc[kt][4 * g + 3] * inv);
                *(LAS v2u*)(L + P_OFF + (qt * 32 + r) * P_STRIDE + (kh * 128 + kt * 32 + 8 * g + 4 * h) * 2) = wv; }
        __syncthreads();
        bf16x8 pf[16];
#pragma unroll
        for (int s = 0; s < 16; ++s) pf[s] = *(const LAS bf16x8*)(L + P_OFF + (qt * 32 + r) * P_STRIDE + (16 * s + 8 * h) * 2);
        const bf16* vbase = vT + (size_t)head * 512 * 512 + b * MEMLEN;
        v4u vst[4];
#pragma unroll
        for (int j = 0; j < 4; ++j) { const int p = tid + 512 * j, row = p >> 5; vst[j] = *(const v4u*)(vbase + (size_t)((row >> 5) * 256 + (row & 31)) * 512 + (p & 31) * 8); }
        for (int i = 0; i < 8; ++i) {
#pragma unroll
            for (int j = 0; j < 4; ++j) { const int p = tid + 512 * j; *(LAS v4u*)(L + KV_OFF + (p >> 5) * V_STRIDE + (p & 31) * 16) = vst[j]; }
            __syncthreads();
            if (i < 7) {
#pragma unroll
                for (int j = 0; j < 4; ++j) { const int p = tid + 512 * j, row = p >> 5; vst[j] = *(const v4u*)(vbase + (size_t)((row >> 5) * 256 + (i + 1) * 32 + (row & 31)) * 512 + (p & 31) * 8); }
            }
            f32x16 acc;
#pragma unroll
            for (int k = 0; k < 16; ++k) acc[k] = 0.f;
#pragma unroll
            for (int s = 0; s < 16; ++s) { const bf16x8 vf = *(const LAS bf16x8*)(L + KV_OFF + (kh * 32 + r) * V_STRIDE + (16 * s + 8 * h) * 2); acc = MFMA32(vf, pf[s], acc); }
            bf16* op = ox + (row0 + qt * 32 + r) * D + head * 512 + (kh * 8 + i) * 32 + 4 * h;
#pragma unroll
            for (int g = 0; g < 4; ++g) { v2u wv; wv.x = pk2(acc[4 * g], acc[4 * g + 1]); wv.y = pk2(acc[4 * g + 2], acc[4 * g + 3]); *(v2u*)(op + 8 * g) = wv; }
            __syncthreads();
        }
    }
}
__device__ __forceinline__ int crow16(int i, int hh) { return (i & 3) + 8 * (i >> 2) + 4 * hh; }
__device__ __forceinline__ bf16x8 pack8(const f32x16& x, int s) {
    v4u p; p.x = pk2(x[8 * s], x[8 * s + 1]); p.y = pk2(x[8 * s + 2], x[8 * s + 3]); p.z = pk2(x[8 * s + 4], x[8 * s + 5]); p.w = pk2(x[8 * s + 6], x[8 * s + 7]);
    return __builtin_bit_cast(bf16x8, p);
}
__device__ __forceinline__ bf16x8 vt_frag(const LAS unsigned char* p) {
    const v2u lo = *(const LAS v2u*)p, hi = *(const LAS v2u*)(p + 16); v4u w; w.x = lo.x; w.y = lo.y; w.z = hi.x; w.w = hi.y; return __builtin_bit_cast(bf16x8, w);
}
__device__ __forceinline__ void vt_scatter(LAS unsigned char* vt, int stride, int c16, int key, v4u w) {
    LAS unsigned short* p = (LAS unsigned short*)(vt + (c16 * 8) * stride + key * 2); const int st = stride / 2;
    p[0] = (unsigned short)w.x; p[st] = (unsigned short)(w.x >> 16); p[2 * st] = (unsigned short)w.y; p[3 * st] = (unsigned short)(w.y >> 16);
    p[4 * st] = (unsigned short)w.z; p[5 * st] = (unsigned short)(w.z >> 16); p[6 * st] = (unsigned short)w.w; p[7 * st] = (unsigned short)(w.w >> 16);
}
__device__ __forceinline__ void p2_swa_mfma(Frame& F, int uc, int uG) {
    const bf16* proj = WSP(bf16, WS_PROJ); bf16* oa = WSP(bf16, WS_OAB);
    const float* relb = F.in[4]; const float* sinks = F.in[7];
    LAS unsigned char* L = F.lds + RING_OFF;
    constexpr int K_OFF = 0, K_STRIDE = 144, VT_OFF = 192 * K_STRIDE, VT_STRIDE = 392, BT_OFF = VT_OFF + 64 * VT_STRIDE;
    static_assert(BT_OFF + 8 * 256 * 4 <= RING_BYTES && BT_OFF % 16 == 0, "swa LDS map");
    const int w = F.wave, r = F.lane & 31, hh = F.lane >> 5, tid = F.tid;
    for (int u = uc; u < 256; u += uG) {
        const int b = u >> 7, g = (u >> 6) & 1, c = u & 63, h = g * 8 + w;
        const int k_lo = (c >= 2 ? c - 2 : 0) * 64, nk = c * 64 + 64 - k_lo, nkt = nk >> 5;
        const bf16* kvbase = proj + ((size_t)b * SEQ + k_lo) * NIN + g * 64;
#pragma unroll
        for (int j = 0; j < 3; ++j) { const int p = tid + 512 * j;
            if (p < nk * 8) { const int key = p >> 3, c16 = p & 7; const bf16* src = kvbase + (size_t)key * NIN + c16 * 8;
                *(LAS v4u*)(L + K_OFF + key * K_STRIDE + c16 * 16) = *(const v4u*)(src + C_KA);
                vt_scatter(L + VT_OFF, VT_STRIDE, c16, key, *(const v4u*)(src + C_VA)); } }
        LAS float* tab = (LAS float*)(L + BT_OFF) + w * 256;
#pragma unroll
        for (int j = 0; j < 4; ++j) { const int idx = F.lane + 64 * j; if (idx < 255) tab[idx] = relb[t5_bucket(idx - 191) * 16 + h]; }
        __syncthreads();
        const float sink = sinks[h];
        const int ibase = k_lo - c * 64 + 191;
#pragma unroll 1
        for (int qt = 0; qt < 2; ++qt) {
            const size_t row = (size_t)b * SEQ + c * 64 + qt * 32 + r;
            bf16x8 qf[4];
#pragma unroll
            for (int s = 0; s < 4; ++s) qf[s] = *(const bf16x8*)(proj + row * NIN + C_QA + h * 64 + 16 * s + 8 * hh);
            f32x16 sacc[6];
#pragma unroll
            for (int kt = 0; kt < 6; ++kt)
#pragma unroll
                for (int i = 0; i < 16; ++i) sacc[kt][i] = 0.f;
#pragma unroll
            for (int kt = 0; kt < 6; ++kt) if (kt < nkt) {
#pragma unroll
                for (int s = 0; s < 4; ++s) { const bf16x8 kf = *(const LAS bf16x8*)(L + K_OFF + (kt * 32 + r) * K_STRIDE + (16 * s + 8 * hh) * 2); sacc[kt] = MFMA32(kf, qf[s], sacc[kt]); } }
            float m = sink;
#pragma unroll
            for (int kt = 0; kt < 6; ++kt) if (kt < nkt) {
#pragma unroll
                for (int i = 0; i < 16; ++i) { const float sv = sacc[kt][i] * 0.125f + tab[ibase + kt * 32 + crow16(i, hh) - qt * 32 - r]; sacc[kt][i] = sv; m = fmaxf(m, sv); } }
            m = fmaxf(m, __shfl_xor(m, 32));
            float lsum = 0.f;
#pragma unroll
            for (int kt = 0; kt < 6; ++kt) if (kt < nkt) {
#pragma unroll
                for (int i = 0; i < 16; ++i) { const float p = __expf(sacc[kt][i] - m); sacc[kt][i] = p; lsum += p; } }
            lsum += __shfl_xor(lsum, 32);
            const float inv = 1.0f / (lsum + __expf(sink - m));
            f32x16 oacc[2];
#pragma unroll
            for (int dt = 0; dt < 2; ++dt)
#pragma unroll
                for (int i = 0; i < 16; ++i) oacc[dt][i] = 0.f;
#pragma unroll
            for (int kt = 0; kt < 6; ++kt) if (kt < nkt) {
#pragma unroll
                for (int i = 0; i < 16; ++i) sacc[kt][i] *= inv;
#pragma unroll
                for (int s = 0; s < 2; ++s) { const bf16x8 pf = pack8(sacc[kt], s);
#pragma unroll
                    for (int dt = 0; dt < 2; ++dt) { const bf16x8 vf = vt_frag(L + VT_OFF + (dt * 32 + r) * VT_STRIDE + (kt * 32 + 16 * s + 4 * hh) * 2); oacc[dt] = MFMA32(vf, pf, oacc[dt]); } } }
            bf16* op = oa + row * 2048 + h * 64 + 4 * hh;
#pragma unroll
            for (int dt = 0; dt < 2; ++dt)
#pragma unroll
                for (int gq = 0; gq < 4; ++gq) { v2u wv; wv.x = pk2(oacc[dt][4 * gq], oacc[dt][4 * gq + 1]); wv.y = pk2(oacc[dt][4 * gq + 2], oacc[dt][4 * gq + 3]); *(v2u*)(op + dt * 32 + 8 * gq) = wv; }
        }
        __syncthreads();
    }
}
__device__ __forceinline__ void p2_sb_mfma(Frame& F, int uc, int uG) {
    const bf16* proj = WSP(bf16, WS_PROJ); bf16* ob = WSP(bf16, WS_OAB) + 1024;
    LAS unsigned char* L = F.lds + RING_OFF;
    constexpr int K_OFF = 0, K_STRIDE = 144, VT_OFF = 448 * K_STRIDE, VT_STRIDE = 904, FL_OFF = VT_OFF + 64 * VT_STRIDE;
    static_assert(FL_OFF + 64 <= RING_BYTES && VT_OFF % 16 == 0, "sb LDS map");
    const int w = F.wave, r = F.lane & 31, hh = F.lane >> 5, tid = F.tid;
    const float LOG2E = 1.4426950408889634f, LN2 = 0.6931471805599453f;
    for (int u = uc; u < 512; u += uG) {
        const int b = u >> 8, h = (u >> 4) & 15, qb = u & 15, q0 = qb * 256, tstart = q0 + 32 * w, t = tstart + r;
        const size_t row = (size_t)b * SEQ + t;
        bf16x8 qf[4];
#pragma unroll
        for (int s = 0; s < 4; ++s) qf[s] = *(const bf16x8*)(proj + row * NIN + C_QB + h * 64 + 16 * s + 8 * hh);
        f32x16 oacc[2];
#pragma unroll
        for (int dt = 0; dt < 2; ++dt)
#pragma unroll
            for (int i = 0; i < 16; ++i) oacc[dt][i] = 0.f;
        float R = 0.f; bool done = false;
        int whi = q0 + 256, wlo = q0 >= 192 ? q0 - 192 : 0;
        for (;;) {
            const int nk = whi - wlo; const bf16* kvbase = proj + ((size_t)b * SEQ + wlo) * NIN + h * 64;
#pragma unroll
            for (int j = 0; j < 7; ++j) { const int p = tid + 512 * j;
                if (p < nk * 8) { const int key = p >> 3, c16 = p & 7; const bf16* src = kvbase + (size_t)key * NIN + c16 * 8;
                    *(LAS v4u*)(L + K_OFF + key * K_STRIDE + c16 * 16) = *(const v4u*)(src + C_KB);
                    vt_scatter(L + VT_OFF, VT_STRIDE, c16, key, *(const v4u*)(src + C_VB)); } }
            __syncthreads();
            for (int kb = (whi - 32 < tstart ? whi - 32 : tstart); kb >= wlo && !done; kb -= 32) {
                const int kl = kb - wlo;
                f32x16 sacc;
#pragma unroll
                for (int i = 0; i < 16; ++i) sacc[i] = 0.f;
#pragma unroll
                for (int s = 0; s < 4; ++s) { const bf16x8 kf = *(const LAS bf16x8*)(L + K_OFF + (kl + r) * K_STRIDE + (16 * s + 8 * hh) * 2); sacc = MFMA32(kf, qf[s], sacc); }
                float sp[16];
#pragma unroll
                for (int i = 0; i < 16; ++i) { const float z = sacc[i] * 0.125f; const bool on = (kb + crow16(i, hh)) < t;
                    const float e = __builtin_amdgcn_exp2f(-fabsf(z) * LOG2E);
                    const float spv = fmaxf(z, 0.f) + LN2 * __builtin_amdgcn_logf(1.0f + e);
                    sp[i] = on ? spv : 0.f; sacc[i] = on ? z - spv : -1.0e30f; }
                float gs[4], ot[4];
#pragma unroll
                for (int gq = 0; gq < 4; ++gq) { gs[gq] = (sp[4 * gq] + sp[4 * gq + 1]) + (sp[4 * gq + 2] + sp[4 * gq + 3]); ot[gq] = __shfl_xor(gs[gq], 32); }
                const float ps3 = gs[3] + ot[3], ps2 = gs[2] + ot[2], ps1 = gs[1] + ot[1], ps0 = gs[0] + ot[0];
                float ge[4];
                ge[3] = (hh == 0 ? ot[3] : 0.f); ge[2] = (hh == 0 ? ot[2] : 0.f) + ps3; ge[1] = (hh == 0 ? ot[1] : 0.f) + ps3 + ps2; ge[0] = (hh == 0 ? ot[0] : 0.f) + ps3 + ps2 + ps1;
#pragma unroll
                for (int gq = 0; gq < 4; ++gq) {
                    const float base = R - ge[gq];
                    const float e3 = base, e2 = e3 - sp[4 * gq + 3], e1 = e2 - sp[4 * gq + 2], e0 = e1 - sp[4 * gq + 1];
                    sacc[4 * gq + 3] = __builtin_amdgcn_exp2f((sacc[4 * gq + 3] + e3) * LOG2E); sacc[4 * gq + 2] = __builtin_amdgcn_exp2f((sacc[4 * gq + 2] + e2) * LOG2E);
                    sacc[4 * gq + 1] = __builtin_amdgcn_exp2f((sacc[4 * gq + 1] + e1) * LOG2E); sacc[4 * gq] = __builtin_amdgcn_exp2f((sacc[4 * gq] + e0) * LOG2E); }
                R -= (ps0 + ps1) + (ps2 + ps3);
#pragma unroll
                for (int s = 0; s < 2; ++s) { const bf16x8 pf = pack8(sacc, s);
#pragma unroll
                    for (int dt = 0; dt < 2; ++dt) { const bf16x8 vf = vt_frag(L + VT_OFF + (dt * 32 + r) * VT_STRIDE + (kl + 16 * s + 4 * hh) * 2); oacc[dt] = MFMA32(vf, pf, oacc[dt]); } }
                done = __all(R < -104.0f);
            }
            LAS unsigned* fl = (LAS unsigned*)(L + FL_OFF);
            if (F.lane == 0) fl[w] = done ? 1u : 0u;
            __syncthreads();
            bool alld = true;
#pragma unroll
            for (int i = 0; i < 8; ++i) alld = alld && (fl[i] != 0u);
            __syncthreads();
            if (alld || wlo == 0) break;
            whi = wlo; wlo = whi >= 448 ? whi - 448 : 0;
        }
        bf16* op = ob + row * 2048 + h * 64 + 4 * hh;
#pragma unroll
        for (int dt = 0; dt < 2; ++dt)
#pragma unroll
            for (int gq = 0; gq < 4; ++gq) { v2u wv; wv.x = pk2(oacc[dt][4 * gq], oacc[dt][4 * gq + 1]); wv.y = pk2(oacc[dt][4 * gq + 2], oacc[dt][4 * gq + 3]); *(v2u*)(op + dt * 32 + 8 * gq) = wv; }
    }
}
__device__ __forceinline__ void p_ln(Frame& F, const float* src, const float* g, const float* b, float* dstf, bf16* dstb) {
    const int gw = F.vcu * NWAVES + F.wave, NGW = F.G * NWAVES;
    for (int m = gw; m < T; m += NGW) {
        f32x4 v[8]; row_load(v, src + (size_t)m * D, F.lane);
        ln_row(v, g, b, F.lane);
        row_store_f32(v, dstf + (size_t)m * D, F.lane);
        row_store_bf16(v, dstb + (size_t)m * D, F.lane);
    }
}
__device__ __forceinline__ void p9_ln_router(Frame& F) {
    const float* wr = F.in[18]; const float* br = F.in[19];
    int* tok_e = WSP(int, WS_ROUTE); float* tok_g = WSP(float, WS_ROUTE + 131072); int* tok_pos = WSP(int, WS_ROUTE + 262144);
    float* h2f = WSP(float, WS_H2F);
    LAS float* part = (LAS float*)(F.lds + RING_OFF);
    LAS unsigned* lcnt = (LAS unsigned*)(F.lds + RING_OFF + 32768); LAS unsigned* lbase = lcnt + 32; LAS unsigned* lpe = lcnt + 64;
    if (F.tid < 32) lcnt[F.tid] = 0u;
    __syncthreads();
    const int w = F.wave, e = F.lane & 31, hh = F.lane >> 5;
    for (int u = F.vcu; u < T / 32; u += F.G) {
        const int tok0 = u * 32;
#pragma unroll 1
        for (int q = 0; q < 4; ++q) { const int m = tok0 + 4 * w + q;
            f32x4 v[8]; row_load(v, WSP(float, WS_S1) + (size_t)m * D, F.lane);
            ln_row(v, F.in[16], F.in[17], F.lane);
            row_store_f32(v, h2f + (size_t)m * D, F.lane);
            row_store_bf16(v, WSP(bf16, WS_H2B) + (size_t)m * D, F.lane);
            { unsigned* o8 = WSP(unsigned, WS_XS) + (size_t)m * (D / 4);
#pragma unroll
              for (int j = 0; j < 8; ++j) o8[F.lane + 64 * j] = pk4_fp8(v[j][0], v[j][1], v[j][2], v[j][3]); } }
        __syncthreads();
        f32x16 acc;
#pragma unroll
        for (int i = 0; i < 16; ++i) acc[i] = 0.f;
        const float* ap = h2f + (size_t)(tok0 + e) * D + 256 * w + 4 * hh;
        const float* bp = wr + (size_t)(256 * w + 4 * hh) * NE + e;
#pragma unroll 4
        for (int m = 0; m < 32; ++m) { const f32x4 a4 = *(const f32x4*)(ap + 8 * m);
#pragma unroll
            for (int j = 0; j < 4; ++j) acc = __builtin_amdgcn_mfma_f32_32x32x2f32(a4[j], bp[(size_t)(8 * m + j) * NE], acc, 0, 0, 0); }
#pragma unroll
        for (int i = 0; i < 16; ++i) part[(w * 32 + crow16(i, hh)) * 32 + e] = acc[i];
        __syncthreads();
        const float bias = br[e];
#pragma unroll 1
        for (int q = 0; q < 4; ++q) { const int tl = 4 * w + q, m = tok0 + tl;
            float val = bias;
#pragma unroll
            for (int ww = 0; ww < 8; ++ww) val += part[(ww * 32 + tl) * 32 + e];
            float tv[4]; int ti[4];
#pragma unroll
            for (int p = 0; p < 4; ++p) {
                float bv = val; int bi = e;
#pragma unroll
                for (int off = 1; off < 32; off <<= 1) { const float ov = __shfl_xor(bv, off); const int oi = __shfl_xor(bi, off);
                    const bool take = (ov > bv) || (ov == bv && oi < bi); bv = take ? ov : bv; bi = take ? oi : bi; }
                tv[p] = bv; ti[p] = bi;
                val = (e == bi) ? -3.0e38f : val;
            }
            const float e1 = __expf(tv[1] - tv[0]), e2 = __expf(tv[2] - tv[0]), e3 = __expf(tv[3] - tv[0]);
            const float inv = 1.0f / (1.0f + e1 + e2 + e3);
            if (F.lane < 4) {
                const int my_e = F.lane == 0 ? ti[0] : F.lane == 1 ? ti[1] : F.lane == 2 ? ti[2] : ti[3];
                const float my_g = (F.lane == 0 ? 1.0f : F.lane == 1 ? e1 : F.lane == 2 ? e2 : e3) * inv;
                const unsigned lpos = __hip_atomic_fetch_add((LAS unsigned*)&lcnt[my_e], 1u, __ATOMIC_RELAXED, __HIP_MEMORY_SCOPE_WORKGROUP);
                tok_e[m * 4 + F.lane] = my_e; tok_g[m * 4 + F.lane] = my_g; lpe[tl * 4 + F.lane] = (unsigned)my_e | (lpos << 8);
            } }
        __syncthreads();
        if (F.tid < 32) { const unsigned c = lcnt[F.tid]; lbase[F.tid] = c ? __hip_atomic_fetch_add((unsigned*)(F.ctl + CW_CNT + 64 * F.tid), c, RLX_AGENT) : 0u; }
        __syncthreads();
        if (F.tid < 128) { const unsigned x = lpe[F.tid]; tok_pos[tok0 * 4 + F.tid] = (int)(lbase[x & 255u] + (x >> 8)); }
        if (F.tid < 32) lcnt[F.tid] = 0u;
        __syncthreads();
    }
}
__device__ __forceinline__ void p10_scatter(Frame& F) {
    const int gw = F.vcu * NWAVES + F.wave, NGW = F.G * NWAVES;
    LAS int* poff = (LAS int*)(F.lds + RING_OFF);
    int* tab = WSP(int, WS_TAB);
    LAS int* lc = poff + 40;
    if (F.tid < NE) lc[F.tid] = (int)__hip_atomic_load((unsigned*)(F.ctl + CW_CNT + 64 * F.tid), RLX_AGENT);
    __syncthreads();
    if (F.tid == 0) {
        int acc = 0;
        int nbig = 0, nsml = 0;
        for (int e = 0; e < NE; ++e) { const int c = lc[e]; poff[e] = acc;
            const int nt = (c + 255) >> 8;
            if (blockIdx.x == 0) for (int k = 0; k < nt; ++k) { const int t = (acc >> 8) + k; tab[t] = e;
                if (c - 256 * k > 128) tab[256 + nbig++] = t; else tab[448 + nsml++] = t; }
            acc += nt << 8; }
        poff[32] = acc;
        if (blockIdx.x == 0) { tab[192] = acc >> 8; tab[193] = nbig; for (int k = 0; k < nsml; ++k) tab[256 + nbig + k] = tab[448 + k]; }
    }
    __syncthreads();
    if (blockIdx.x == 0) {
        const int rt = poff[32] >> 8;
        for (int pass = 0; pass < 2; ++pass) { const int nN = pass ? 8 : 16, nwg = rt * nN; int* ul = tab + (pass ? 8192 : 1024);
            for (int L = F.tid; L < nwg; L += NWAVES * 64) {
                const int q = nwg / 8, r8 = nwg % 8, xcd = L % 8, off = L / 8; const int wgid = (xcd < r8 ? xcd * (q + 1) : r8 * (q + 1) + (xcd - r8) * q) + off;
                int e = 0;
                for (int k = 1; k < NE; ++k) e = (wgid >= (poff[k] >> 8) * nN) ? k : e;
                const int first = poff[e] >> 8, re = (poff[e + 1] >> 8) - first, local = wgid - first * nN;
                ul[L] = (first + local % re) | ((e * nN + local / re) << 16); } }
    }
    const int* tok_e = WSP(int, WS_ROUTE); const int* tok_pos = WSP(int, WS_ROUTE + 262144); int* tok_row = WSP(int, WS_ROUTE + 393216);
    int* rowtok = WSP(int, WS_XS + 32 * MiB);
    const int gt = F.vcu * NWAVES * 64 + F.tid, NT = F.G * NWAVES * 64;
    for (int p = gt; p < T * 4; p += NT) { const int e = tok_e[p], row = poff[e] + tok_pos[p]; tok_row[p] = row; rowtok[row] = p >> 2; }
    for (int e = 0; e < NE; ++e) { const int c0 = poff[e] + lc[e], c1 = poff[e + 1]; for (int r = c0 + gt; r < c1; r += NT) rowtok[r] = 0; }
    __syncthreads();
}
__device__ __forceinline__ void p13_combine(Frame& F) {
    const int gw = F.vcu * NWAVES + F.wave, NGW = F.G * NWAVES;
    const float* tok_g = WSP(float, WS_ROUTE + 131072); const int* tok_row = WSP(int, WS_ROUTE + 393216);
    const bf16* yr = WSP(bf16, WS_YR);
    for (int m = gw; m < T; m += NGW) {
        f32x4 v[8]; row_load(v, WSP(float, WS_H2F) + (size_t)m * D, F.lane);
#pragma unroll
        for (int j = 0; j < 8; ++j) v[j] = v[j] * ALPHA;
#pragma unroll
        for (int k = 0; k < 4; ++k) { const float g = tok_g[m * 4 + k]; const v2u* yp = (const v2u*)(yr + (size_t)tok_row[m * 4 + k] * D);
#pragma unroll
            for (int j = 0; j < 8; ++j) { const v2u w = yp[F.lane + 64 * j]; v[j][0] += g * bflo(w.x); v[j][1] += g * bfhi(w.x); v[j][2] += g * bflo(w.y); v[j][3] += g * bfhi(w.y); } }
        ln_row(v, F.in[24], F.in[25], F.lane);
        row_store_f32(v, F.out + (size_t)m * D, F.lane);
    }
}

struct Args { const float* in[26]; float* out; unsigned char* ws; int ph_lo, ph_hi; };
__global__ void __launch_bounds__(NWAVES * 64, 2) mk_fwd(Args args) {
    extern __shared__ __attribute__((aligned(16))) unsigned char lds[];
    Frame F;
    F.lds = (LAS unsigned char*)lds;
    F.MISC = (volatile LAS unsigned*)(F.lds + MISC_OFF);
    F.tid = threadIdx.x; F.lane = F.tid & 63; F.wave = __builtin_amdgcn_readfirstlane(F.tid >> 6);
    F.G = gridDim.x; { const int bx = blockIdx.x; F.vcu = (F.G % 8 == 0) ? (bx % 8) * (F.G / 8) + bx / 8 : bx; }
    F.ws = args.ws; F.out = args.out;
    F.in = args.in;
    F.ctl = (gu32*)(F.ws + WS_CTL);
    for (int u = F.tid; u < (LDS_BYTES - LDSCTL_OFF) / 4; u += NWAVES * 64) ((LAS unsigned*)(F.lds + LDSCTL_OFF))[u] = 0u;
    __syncthreads();
    const int lo = args.ph_lo, hi = args.ph_hi;
    const bool multi = (hi - lo) > 1;
    XcdBarrier bar; bar.bar = (unsigned*)(F.ctl + CW_BAR); bar.x = 0; bar.st = nullptr;
    if (multi) bar = xcd_barrier_post((unsigned*)(F.ctl + CW_BAR), F.MISC + 8);
#ifndef P1_CW
#define P1_CW 18
#endif
#ifndef P11_CW
#define P11_CW 28
#endif
#ifndef REPEAT_MASK
#define REPEAT_MASK 0u
#endif
#ifndef PHMASK
#define PHMASK 0xffffffffu
#endif
#define IN(k) ((((PHMASK) >> (k)) & 1u) && lo <= (k) && (k) < hi)
#define RUN(k, ...) do { if (IN(k)) __VA_ARGS__ if (((REPEAT_MASK >> (k)) & 1u) && IN(k)) __VA_ARGS__ } while (0);
#define SEAM(k) do { if (IN(k) && IN((k) + 1)) xcd_barrier(bar); } while (0)
    const int G = F.G, cidx = (int)blockIdx.x;

    RUN(0, { p0_prologue(F); }) SEAM(0);
    const int xi = cidx & 7, pi = cidx >> 3, per_x = G >> 3;
    RUN(1, {
        const bool split = (G % 8 == 0) && per_x > P1_CW;
        if (!split) { cvt_role_p1(F, F.vcu * NWAVES + F.wave, G * NWAVES); if (multi) xcd_barrier(bar); }
        if (!split || pi < P1_CW) {
            pg8::Gemm g{(const bf16*)F.ws, (const bf16*)F.ws, T + 512, NIN + 4096, D}; blk::SchedP1 S; S.init(split ? P1_CW * 8 : G, split ? pi * 8 + xi : cidx);
            blk::EpiProj E{F.ws, F.in[6]};
            pg8::gemm_phase<blk::EpiProj, blk::SchedP1, true, true>(F.lds + RING_OFF, g, S, E);
            if (split) {
                VM_WAIT(); __syncthreads();
                if (F.tid == 0) {
                    __builtin_amdgcn_fence(__ATOMIC_RELEASE, "agent"); VM_WAIT();
                    gu32* cnt = F.ctl + CW_SUB; const unsigned want = (unsigned)(P1_CW * 8);
                    __hip_atomic_fetch_add(cnt, 1u, RLX_AGENT);
                    unsigned sp = 0;
                    while (__hip_atomic_load(cnt, RLX_AGENT) < want) { __builtin_amdgcn_s_sleep(2);
                        if ((++sp & 255u) == 0u) { if (__hip_atomic_load(F.ctl + CW_TMO, RLX_AGENT)) break; if (sp > (1u << 20)) { __hip_atomic_store(F.ctl + CW_TMO, 1u, RLX_AGENT); break; } } }
                    __builtin_amdgcn_fence(__ATOMIC_ACQUIRE, "agent"); VM_WAIT();
                }
                __syncthreads();
                p2_swa_mfma(F, xi * P1_CW + pi, P1_CW * 8); p2_sb_mfma(F, xi * P1_CW + pi, P1_CW * 8);
            }
        } else cvt_role_p1(F, ((pi - P1_CW) * 8 + xi) * NWAVES + F.wave, (per_x - P1_CW) * 8 * NWAVES);
    }) SEAM(1);
    if (!((G % 8 == 0) && per_x > P1_CW)) { RUN(2, { p2_swa_mfma(F, F.vcu, G); p2_sb_mfma(F, F.vcu, G); }) SEAM(2); }
    RUN(3, {
        pg8::Gemm g{WSP(bf16, WS_OAB), WSP(bf16, WS_BTAB), T, D, D}; pg8::StaticOrder S; S.init(T, D, G, cidx);
        blk::EpiGate E{WSP(bf16, WS_PROJ), WSP(bf16, WS_GG)};
        pg8::gemm_phase<blk::EpiGate, pg8::StaticOrder, true, true, false, false, true>(F.lds + RING_OFF, g, S, E);
    }) SEAM(3);
    RUN(4, {
        pg8::Gemm g{WSP(bf16, WS_GG), WSP(bf16, WS_BTMIX), T, D, D}; pg8::StaticOrder S; S.init(T, D, G, cidx);
        blk::EpiRes E{WSP(float, WS_H0F), WSP(float, WS_S1)};
        pg8::gemm_phase<blk::EpiRes, pg8::StaticOrder, true, true>(F.lds + RING_OFF, g, S, E);
    }) SEAM(4);
    RUN(5, { p_ln(F, WSP(float, WS_S1), F.in[11], F.in[12], WSP(float, WS_H1F), WSP(bf16, WS_H1B)); }) SEAM(5);
    RUN(6, {
        pg8::Gemm g{WSP(bf16, WS_H1B), WSP(bf16, WS_BTXQ), T, D, D}; pg8::StaticOrder S; S.init(T, D, G, cidx);
        blk::EpiBf16B E{WSP(bf16, WS_QX), D, nullptr, 0x7fffffff, 31, 0, 1.0f};
        pg8::gemm_phase<blk::EpiBf16B, pg8::StaticOrder, true, true>(F.lds + RING_OFF, g, S, E);
    }) SEAM(6);
    RUN(7, { p7_cross_mfma(F); }) SEAM(7);
    RUN(8, {
        pg8::Gemm g{WSP(bf16, WS_OX), WSP(bf16, WS_BTXO), T, D, D}; pg8::StaticOrder S; S.init(T, D, G, cidx);
        blk::EpiRes E{WSP(float, WS_H1F), WSP(float, WS_S1)};
        pg8::gemm_phase<blk::EpiRes, pg8::StaticOrder, true, true>(F.lds + RING_OFF, g, S, E);
    }) SEAM(8);
    RUN(9, { p9_ln_router(F); }) SEAM(9);
    RUN(10, { p10_scatter(F); }) SEAM(10);
    RUN(11, {
        pg8::Gemm g{WSP(bf16, WS_XS), WSP(bf16, WS_BTUP), RMAX, NE * 4096, D}; blk::SchedMoE S; S.init(WSP(int, WS_TAB), 16, G, cidx, (LAS int*)(F.lds + MISC_OFF + 256), F.tid, WSP(int, WS_XS + 32 * MiB));
        blk::EpiSwiGLU E{WSP(unsigned char, WS_ACT), F.in[21]};
        pg8::gemm_phase<blk::EpiSwiGLU, blk::SchedMoE, true, true, false, true, false, true>(F.lds + RING_OFF, g, S, E);
    }) SEAM(11);
    RUN(12, {
        pg8::Gemm g{WSP(bf16, WS_ACT), WSP(bf16, WS_BTDN), RMAX, NE * 2048, FF}; blk::SchedMoE S; S.init(WSP(int, WS_TAB), 8, G, cidx, (LAS int*)(F.lds + MISC_OFF + 256), F.tid);
        blk::EpiBf16B E{WSP(bf16, WS_YR), D, F.in[23], 7, 3, 2048, W8_INV};
        pg8::gemm_phase<blk::EpiBf16B, blk::SchedMoE, true, true, false, true>(F.lds + RING_OFF, g, S, E);
    }) SEAM(12);
    RUN(13, { p13_combine(F); })
#undef IN
#undef SEAM
}

extern "C" void kernel_launch(void* const* d_in, const int* in_sizes, int n_in, void* d_out, int out_size, void* d_ws, size_t ws_size, hipStream_t stream) {
    static int grid = 0;
    if (grid == 0) {
        if (n_in != 26 || out_size != T * D || ws_size < WS_END) { fprintf(stderr, "kernel_launch: unexpected shapes: n_in %d out %d ws %zu (need %zu)\n", n_in, out_size, ws_size, (size_t)WS_END); grid = -1; return; }
        int dev = 0, cus = 0, per_cu = 0;
        if (hipGetDevice(&dev) != hipSuccess || hipDeviceGetAttribute(&cus, hipDeviceAttributeMultiprocessorCount, dev) != hipSuccess) { grid = -1; return; }
        if (hipFuncSetAttribute((const void*)mk_fwd, hipFuncAttributeMaxDynamicSharedMemorySize, LDS_BYTES) != hipSuccess) { fprintf(stderr, "kernel_launch: hipFuncSetAttribute failed\n"); grid = -1; return; }
        if (hipOccupancyMaxActiveBlocksPerMultiprocessor(&per_cu, (const void*)mk_fwd, NWAVES * 64, LDS_BYTES) != hipSuccess || per_cu < 1)
            fprintf(stderr, "kernel_launch: occupancy query reports %d workgroups per CU\n", per_cu);
        (void)hipGetLastError();
        grid = cus;
    }
    if (grid < 0) return;
    if (hipMemsetAsync((char*)d_ws + WS_CTL, 0, CTL_ZERO_BYTES, stream) != hipSuccess) return;
    Args a{};
    for (int i = 0; i < 26; ++i) a.in[i] = (const float*)d_in[i];
    a.out = (float*)d_out; a.ws = (unsigned char*)d_ws;
#if MK_ONE_LAUNCH
    a.ph_lo = 0; a.ph_hi = NPHASE;
    hipLaunchKernelGGL(mk_fwd, dim3(grid), dim3(NWAVES * 64), LDS_BYTES, stream, a);
#else
    for (int ph = 0; ph < NPHASE; ++ph) { a.ph_lo = ph; a.ph_hi = ph + 1;
        hipLaunchKernelGGL(mk_fwd, dim3(grid), dim3(NWAVES * 64), LDS_BYTES, stream, a); }
#endif
}
```

```cpp
#include <hip/hip_runtime.h>
#include <cstdio>
#include <cstdint>
namespace pg8 {
#define PG8_LAS __attribute__((address_space(3)))
typedef unsigned short bf16_t;
typedef short bf16x8 __attribute__((ext_vector_type(8)));
typedef float f32x4 __attribute__((ext_vector_type(4)));
typedef unsigned u32x4 __attribute__((ext_vector_type(4)));
constexpr int BM = 256, BK = 64, HALF = 128, HTB = HALF * BK * 2  , STAGE_BYTES = 8 * HTB, NXCD = 8, WGM = 8;

__host__ __device__ __forceinline__ int lds_byte(int r, int c) { const int st = (r >> 4) * 2 + (c >> 5), rr = r & 15, cc = c & 31, ob = rr * 64 + cc * 2; return st * 1024 + (ob ^ (((ob >> 9) & 1) << 5)); }
__host__ __device__ __forceinline__ void stage_rc(int b, int& R, int& C) { const int st = b / 1024, sb = b % 1024, swz = sb ^ (((sb >> 9) & 1) << 5); R = (st >> 1) * 16 + swz / 64; C = (st & 1) * 32 + (swz % 64) / 2; }
__host__ __device__ __forceinline__ int perm32(int rho) { const int n = rho >> 4, i = rho & 15; return 8 * (i >> 2) + 4 * n + (i & 3); }

struct Unit { int pm, pn, rm, rn; };
struct Gemm { const bf16_t* A; const bf16_t* Bt; int M, N, K; };

struct StaticOrder {
    int nM, nN, nwg, G, c;
    __host__ __device__ void init(int M, int N, int G_, int c_) { nM = M / BM; nN = N / BM; nwg = nM * nN; G = G_; c = c_; }
    __host__ __device__ __forceinline__ bool next(int i, Unit& u) const {
        const long L = (long)i * G + c; if (L >= nwg) return false;
        int wgid = (int)L; { const int q = nwg / NXCD, r = nwg % NXCD, xcd = wgid % NXCD, off = wgid / NXCD; wgid = (xcd < r ? xcd * (q + 1) : r * (q + 1) + (xcd - r) * q) + off; }
        const int nig = WGM * nN, gid = wgid / nig, fm = gid * WGM, gsz = (nM - fm) < WGM ? (nM - fm) : WGM;
        u.pm = fm + ((wgid % nig) % gsz); u.pn = (wgid % nig) / gsz; return true;
    }
    __device__ __forceinline__ void a_ready(const Unit&) const {}
    __device__ __forceinline__ void done(const Unit&) const {}
};
typedef int i32x8 __attribute__((ext_vector_type(8)));
__device__ __forceinline__ i32x8 ld8(const PG8_LAS unsigned char* p) { typedef int i32x4 __attribute__((ext_vector_type(4))); const i32x4 a = *(const PG8_LAS i32x4*)p, b = *(const PG8_LAS i32x4*)(p + 1024); return __builtin_shufflevector(a, b, 0, 1, 2, 3, 4, 5, 6, 7); }
__device__ __forceinline__ i32x8 cat8(bf16x8 lo, bf16x8 hi) { typedef int i32x4 __attribute__((ext_vector_type(4))); const i32x4 a = __builtin_bit_cast(i32x4, lo), b = __builtin_bit_cast(i32x4, hi); return (i32x8){a[0], a[1], a[2], a[3], b[0], b[1], b[2], b[3]}; }
template <class Epi, class Sched, bool ALIGN_EPI = false, bool SP2 = false, bool HALFCAP = false, bool FP8 = false, bool MIDHOOK = false, bool GATHER = false>
__device__ __forceinline__ void gemm_phase(PG8_LAS unsigned char* lds, const Gemm g, const Sched& S, const Epi& E) {
    const int tid = threadIdx.x, wid = __builtin_amdgcn_readfirstlane(tid >> 6), lane = tid & 63, wr = wid >> 2, wc = wid & 3, fr = lane & 15, fq = lane >> 4;
    const int K = FP8 ? g.K / 2 : g.K, nt = K / BK;
    unsigned voffA[2], voffB[2];
#pragma unroll
    for (int i = 0; i < 2; ++i) { int R, C; stage_rc(tid * 16 + i * 8192, R, C); const int Rb = Epi::PERM ? ((R & ~31) + perm32(R & 31)) : R;
        voffA[i] = (unsigned)(R * K + C) * 2u; voffB[i] = (unsigned)(Rb * K + C) * 2u; }
    const size_t kstep = (size_t)(BK * 2);
    const size_t hstep = (size_t)HALF * K * 2;
    const size_t tstep = 2 * hstep;
    const unsigned ldsw = (unsigned)wid * 1024u;
    const int aoff = lds_byte(wr * 64 + fr, fq * 8), boff = lds_byte(wc * 32 + fr, fq * 8);
#define PG8_SA(b, h) (((b) * 2 + (h)) * HTB)
#define PG8_SB(b, h) ((4 + (b) * 2 + (h)) * HTB)
#define PG8_STAGE(bufoff, gbase, voff) do { _Pragma("unroll") for (int _i = 0; _i < 2; ++_i) \
        __builtin_amdgcn_global_load_lds((const unsigned*)((const char*)(gbase) + (voff)[_i]), (PG8_LAS unsigned*)(lds + (bufoff) + ldsw + _i * 8192), 16, 0, 0); } while (0)
#define PG8_LDA(dst, b, h) do { if constexpr (FP8) { _Pragma("unroll") for (int m = 0; m < 4; ++m) dst##8[m] = ld8(lds + PG8_SA(b, h) + aoff + m * 2048); } else { _Pragma("unroll") for (int m = 0; m < 4; ++m) _Pragma("unroll") for (int k = 0; k < 2; ++k) dst[m][k] = *(const PG8_LAS bf16x8*)(lds + PG8_SA(b, h) + aoff + m * 2048 + k * 1024); } } while (0)
#define PG8_LDB(dst, b, h) do { if constexpr (FP8) { _Pragma("unroll") for (int n = 0; n < 2; ++n) dst##8[n] = ld8(lds + PG8_SB(b, h) + boff + n * 2048); } else { _Pragma("unroll") for (int n = 0; n < 2; ++n) _Pragma("unroll") for (int k = 0; k < 2; ++k) dst[n][k] = *(const PG8_LAS bf16x8*)(lds + PG8_SB(b, h) + boff + n * 2048 + k * 1024); } } while (0)
#define PG8_MMA(ai, bj, At, Bt) do { __builtin_amdgcn_s_setprio(1); _Pragma("unroll") for (int m = 0; m < 4; ++m) _Pragma("unroll") for (int n = 0; n < 2; ++n) { \
        if constexpr (FP8) { asm volatile("v_mfma_scale_f32_16x16x128_f8f6f4 %0, %1, %2, %0, %3, %3 op_sel_hi:[0,0,0]" : "+v"(acc[ai][bj][m][n]) : "v"(Bt##8[n]), "v"(At##8[m]), "v"(sc_one)); } \
        else { _Pragma("unroll") for (int k = 0; k < 2; ++k) acc[ai][bj][m][n] = __builtin_amdgcn_mfma_f32_16x16x32_bf16(Bt[n][k], At[m][k], acc[ai][bj][m][n], 0, 0, 0); } } __builtin_amdgcn_s_setprio(0); } while (0)
#define PG8_WAIT_V(n) asm volatile("s_waitcnt vmcnt(" #n ")" ::: "memory")
#define PG8_WAIT_L(n) asm volatile("s_waitcnt lgkmcnt(" #n ")" ::: "memory")
#define PG8_BAR __builtin_amdgcn_s_barrier()
#define PG8_SCHED __builtin_amdgcn_sched_barrier(0)
    Unit cur, nxt; int ui = 0;
    if (!S.next(0, cur)) return;
    f32x4 acc[2][2][4][2];
#pragma unroll
    for (int a = 0; a < 2; ++a)
#pragma unroll
        for (int b = 0; b < 2; ++b)
#pragma unroll
            for (int m = 0; m < 4; ++m)
#pragma unroll
                for (int n = 0; n < 2; ++n) acc[a][b][m][n] = (f32x4){0.f, 0.f, 0.f, 0.f};
    bf16x8 At[4][2], B0[2][2], B1[2][2];
    i32x8 At8[4], B08[2], B18[2]; const int sc_one = 0x7f7f7f7f;
    const char* cA = (const char*)g.A + (size_t)cur.pm * tstep; const char* cB = (const char*)g.Bt + (size_t)cur.pn * tstep;
    S.a_ready(cur);
    unsigned cof[2][2] = {{0u, 0u}, {0u, 0u}}, nof[2][2] = {{0u, 0u}, {0u, 0u}}; int gR[2] = {0, 0}; unsigned gC[2] = {0u, 0u};
    if constexpr (GATHER) {
#pragma unroll
        for (int i = 0; i < 2; ++i) { int R, C; stage_rc(tid * 16 + i * 8192, R, C); gR[i] = R; gC[i] = (unsigned)C * 2u; }
#pragma unroll
        for (int h = 0; h < 2; ++h)
#pragma unroll
            for (int i = 0; i < 2; ++i) cof[h][i] = (unsigned)S.row_of(0, h * HALF + gR[i]) * (unsigned)(2 * K) + gC[i];
    }
#define PG8_STAGE_GA(bufoff, h, use_next, kb) do { const unsigned _o0 = (use_next) ? nof[h][0] : cof[h][0], _o1 = (use_next) ? nof[h][1] : cof[h][1]; const char* _gb = (const char*)g.A + (kb); \
        __builtin_amdgcn_global_load_lds((const unsigned*)(_gb + _o0), (PG8_LAS unsigned*)(lds + (bufoff) + ldsw), 16, 0, 0); \
        __builtin_amdgcn_global_load_lds((const unsigned*)(_gb + _o1), (PG8_LAS unsigned*)(lds + (bufoff) + ldsw + 8192), 16, 0, 0); } while (0)
    if constexpr (SP2) {
        PG8_STAGE(PG8_SB(0, 0), cB, voffB); PG8_STAGE(PG8_SB(0, 1), cB + hstep, voffB);
        if constexpr (GATHER) { PG8_STAGE_GA(PG8_SA(0, 0), 0, false, 0); PG8_STAGE_GA(PG8_SA(0, 1), 1, false, 0); } else { PG8_STAGE(PG8_SA(0, 0), cA, voffA); PG8_STAGE(PG8_SA(0, 1), cA + hstep, voffA); }
        if (wr == 1) PG8_BAR;
        PG8_WAIT_V(2); PG8_BAR;
        PG8_STAGE(PG8_SB(1, 0), cB + kstep, voffB); if constexpr (GATHER) PG8_STAGE_GA(PG8_SA(1, 0), 0, false, kstep); else PG8_STAGE(PG8_SA(1, 0), cA + kstep, voffA); PG8_STAGE(PG8_SB(1, 1), cB + hstep + kstep, voffB);
        PG8_WAIT_V(6); PG8_BAR;
    } else {
        PG8_STAGE(PG8_SB(0, 0), cB, voffB); PG8_STAGE(PG8_SA(0, 0), cA, voffA); PG8_STAGE(PG8_SB(0, 1), cB + hstep, voffB); PG8_STAGE(PG8_SA(0, 1), cA + hstep, voffA);
        if (wr == 1) PG8_BAR;
        PG8_WAIT_V(4); PG8_BAR;
        PG8_STAGE(PG8_SB(1, 0), cB + kstep, voffB); PG8_STAGE(PG8_SA(1, 0), cA + kstep, voffA); PG8_STAGE(PG8_SB(1, 1), cB + hstep + kstep, voffB);
        PG8_WAIT_V(6); PG8_BAR;
    }
    for (;;) {
        const bool has_next = S.next(ui + 1, nxt);
        const char* nA = has_next ? (const char*)g.A + (size_t)nxt.pm * tstep : cA; const char* nB = has_next ? (const char*)g.Bt + (size_t)nxt.pn * tstep : cB;
        const bool half = HALFCAP && cur.rm != 0;
        if constexpr (GATHER) {
#pragma unroll
            for (int h = 0; h < 2; ++h)
#pragma unroll
                for (int i = 0; i < 2; ++i) nof[h][i] = has_next ? (unsigned)S.row_of(ui + 1, h * HALF + gR[i]) * (unsigned)(2 * K) + gC[i] : cof[h][i];
        }
        for (int t = 0; t < nt; t += 2) {
            const bool last = (t == nt - 2);
            const char* a1 = cA + (size_t)(t + 1) * kstep;
            const char* a2 = last ? nA : cA + (size_t)(t + 2) * kstep; const char* b2 = last ? nB : cB + (size_t)(t + 2) * kstep;
            const char* a3 = a2 + kstep; const char* b3 = b2 + kstep;
            if constexpr (MIDHOOK) { if (t == nt / 2) E.mid(acc, cur, wr, wc, fr, fq); }
            if (last && has_next) S.a_ready(nxt);
            if constexpr (SP2) {
            PG8_LDB(B0, 0, 0); PG8_LDB(B1, 0, 1); PG8_SCHED; PG8_LDA(At, 0, 0); if constexpr (GATHER) PG8_STAGE_GA(PG8_SA(1, 1), 1, false, (size_t)(t + 1) * kstep); else PG8_STAGE(PG8_SA(1, 1), a1 + hstep, voffA);
            PG8_WAIT_V(8); PG8_WAIT_L(0); PG8_BAR; PG8_MMA(0, 0, At, B0); PG8_MMA(0, 1, At, B1); PG8_BAR; PG8_SCHED;
            if (!half) PG8_LDA(At, 0, 1); PG8_STAGE(PG8_SB(0, 0), b2, voffB); PG8_STAGE(PG8_SB(0, 1), b2 + hstep, voffB); if constexpr (GATHER) PG8_STAGE_GA(PG8_SA(0, 0), 0, last, last ? (size_t)0 : (size_t)(t + 2) * kstep); else PG8_STAGE(PG8_SA(0, 0), a2, voffA);
            PG8_WAIT_V(8); PG8_WAIT_L(0); PG8_BAR; if (!half) { PG8_MMA(1, 0, At, B0); PG8_MMA(1, 1, At, B1); } PG8_BAR; PG8_SCHED;
            PG8_LDB(B0, 1, 0); PG8_LDB(B1, 1, 1); PG8_SCHED; PG8_LDA(At, 1, 0); if constexpr (GATHER) PG8_STAGE_GA(PG8_SA(0, 1), 1, last, last ? (size_t)0 : (size_t)(t + 2) * kstep); else PG8_STAGE(PG8_SA(0, 1), a2 + hstep, voffA);
            PG8_WAIT_V(8); PG8_WAIT_L(0); PG8_BAR; PG8_MMA(0, 0, At, B0); PG8_MMA(0, 1, At, B1); PG8_BAR; PG8_SCHED;
            if (!half) PG8_LDA(At, 1, 1); PG8_STAGE(PG8_SB(1, 0), b3, voffB); PG8_STAGE(PG8_SB(1, 1), b3 + hstep, voffB); if constexpr (GATHER) PG8_STAGE_GA(PG8_SA(1, 0), 0, last, last ? kstep : (size_t)(t + 3) * kstep); else PG8_STAGE(PG8_SA(1, 0), a3, voffA);
            PG8_WAIT_V(8); PG8_WAIT_L(0); PG8_BAR; if (!half) { PG8_MMA(1, 0, At, B0); PG8_MMA(1, 1, At, B1); } PG8_BAR; PG8_SCHED;
            } else {
            PG8_LDB(B0, 0, 0); PG8_SCHED; PG8_LDA(At, 0, 0); PG8_STAGE(PG8_SA(1, 1), a1 + hstep, voffA);
            PG8_WAIT_L(8); PG8_BAR; PG8_WAIT_L(0); PG8_MMA(0, 0, At, B0); PG8_BAR; PG8_SCHED;
            PG8_LDB(B1, 0, 1); PG8_STAGE(PG8_SB(0, 0), b2, voffB);
            PG8_BAR; PG8_WAIT_L(0); PG8_MMA(0, 1, At, B1); PG8_BAR;
            PG8_LDA(At, 0, 1); PG8_STAGE(PG8_SA(0, 0), a2, voffA);
            PG8_BAR; PG8_WAIT_L(0); PG8_MMA(1, 0, At, B0); PG8_BAR; PG8_SCHED;
            PG8_STAGE(PG8_SB(0, 1), b2 + hstep, voffB);
            PG8_WAIT_V(6); PG8_BAR; PG8_MMA(1, 1, At, B1); PG8_BAR;
            PG8_LDB(B0, 1, 0); PG8_SCHED; PG8_LDA(At, 1, 0); PG8_STAGE(PG8_SA(0, 1), a2 + hstep, voffA);
            PG8_WAIT_L(8); PG8_BAR; PG8_WAIT_L(0); PG8_MMA(0, 0, At, B0); PG8_BAR; PG8_SCHED;
            PG8_LDB(B1, 1, 1); PG8_STAGE(PG8_SB(1, 0), b3, voffB);
            PG8_BAR; PG8_WAIT_L(0); PG8_MMA(0, 1, At, B1); PG8_BAR;
            PG8_LDA(At, 1, 1); PG8_STAGE(PG8_SA(1, 0), a3, voffA);
            PG8_BAR; PG8_WAIT_L(0); PG8_MMA(1, 0, At, B0); PG8_BAR; PG8_SCHED;
            PG8_STAGE(PG8_SB(1, 1), b3 + hstep, voffB);
            PG8_WAIT_V(6); PG8_BAR; PG8_MMA(1, 1, At, B1); PG8_BAR;
            }
        }
        if constexpr (FP8) asm volatile("s_nop 15\n\ts_nop 15" ::: "memory");
        if constexpr (ALIGN_EPI) { if (wr == 0) PG8_BAR; }
        if constexpr (!Epi::AFTER_DRAIN) { E(acc, cur, wr, wc, fr, fq); S.done(cur); }
        if (!has_next) break;
#pragma unroll
        for (int a = 0; a < 2; ++a)
#pragma unroll
            for (int b = 0; b < 2; ++b)
#pragma unroll
                for (int m = 0; m < 4; ++m)
#pragma unroll
                    for (int n = 0; n < 2; ++n) acc[a][b][m][n] = (f32x4){0.f, 0.f, 0.f, 0.f};
        cur = nxt; cA = nA; cB = nB; ++ui;
        if constexpr (GATHER) { cof[0][0] = nof[0][0]; cof[0][1] = nof[0][1]; cof[1][0] = nof[1][0]; cof[1][1] = nof[1][1]; }
        if constexpr (ALIGN_EPI) { if (wr == 1) PG8_BAR; }
    }
    PG8_WAIT_V(0);
    if constexpr (!ALIGN_EPI) { if (wr == 0) PG8_BAR; }
    PG8_BAR;
    if constexpr (Epi::AFTER_DRAIN) { E.fused(acc, cur, wr, wc, fr, fq, lds, wid, lane); S.done(cur); }
#undef PG8_SA
#undef PG8_SB
#undef PG8_STAGE
#undef PG8_STAGE_GA
#undef PG8_LDA
#undef PG8_LDB
#undef PG8_MMA
#undef PG8_WAIT_V
#undef PG8_WAIT_L
#undef PG8_BAR
#undef PG8_SCHED
}
}

constexpr int NB = 2, SEQ = 4096, T = NB * SEQ, D = 2048, NIN = 8448;
constexpr int C_QA = 0, C_KA = 1024, C_VA = 1152, C_QB = 1280, C_KB = 2304, C_VB = 3328, C_GA = 4352, C_GB = 6400;
constexpr int NE = 32, FF = 2048, MEMLEN = 256;
constexpr int RMAX = 32768 + NE * 256;
constexpr float ALPHA = 1.18920711500272f;
constexpr float LN_EPS = 1e-5f;
constexpr int NWAVES = 8;
#ifndef MK_ONE_LAUNCH
#define MK_ONE_LAUNCH 1
#endif
constexpr int NPHASE = 14;

constexpr size_t MiB = 1u << 20;
constexpr size_t WS_CTL = 0, CTL_ZERO_BYTES = 65536;
constexpr size_t WS_TAB = 1 * MiB;
constexpr size_t WS_ROUTE = 2 * MiB;
constexpr size_t WS_BT1 = 4 * MiB;
constexpr size_t WS_BTAB = 54 * MiB;
constexpr size_t WS_BTMIX = 62 * MiB, WS_BTXQ = 70 * MiB, WS_BTXO = 78 * MiB;
constexpr size_t WS_BTUP = 88 * MiB;
constexpr size_t WS_BTDN = 600 * MiB;
constexpr size_t WS_H0F = 856 * MiB;
constexpr size_t WS_H0B = 920 * MiB;
constexpr size_t WS_PROJ = 954 * MiB;
constexpr size_t WS_KMEM = 1086 * MiB;
constexpr size_t WS_VT = 1088 * MiB;
constexpr size_t WS_OAB = 1090 * MiB;
constexpr size_t WS_G1 = 1122 * MiB;
constexpr size_t WS_GG = 1186 * MiB;
constexpr size_t WS_S1 = 1218 * MiB;
constexpr size_t WS_H1F = 1282 * MiB, WS_H1B = 1346 * MiB, WS_QX = 1378 * MiB, WS_OX = 1410 * MiB, WS_H2F = 1442 * MiB, WS_H2B = 1506 * MiB;
constexpr size_t WS_XS = 1538 * MiB, WS_ACT = 1698 * MiB, WS_YR = 1858 * MiB, WS_END = 2018 * MiB;
static_assert(WS_BT1 + (size_t)12544 * 2048 * 2 <= WS_BTAB && WS_H0B + (size_t)8704 * 2048 * 2 <= WS_PROJ && WS_PROJ + (size_t)T * NIN * 2 <= WS_KMEM && WS_XS + (size_t)RMAX * 2048 * 2 <= WS_ACT, "ws map");

constexpr int CW_TMO = 0, CW_CODE = 1;
constexpr int CW_CNT = 1024;
constexpr int CW_SUB = 3584;
constexpr int CW_BAR = 4096;

constexpr int RING_OFF = 0, RING_BYTES = 131072;
constexpr int LDSCTL_OFF = RING_BYTES, MISC_OFF = LDSCTL_OFF + 320;
constexpr int LDS_BYTES = 147456;

#define GAS __attribute__((address_space(1)))
#define LAS __attribute__((address_space(3)))
typedef unsigned short bf16;
typedef unsigned v4u __attribute__((ext_vector_type(4)));
typedef unsigned v2u __attribute__((ext_vector_type(2)));
typedef float f32x4 __attribute__((ext_vector_type(4)));
typedef GAS unsigned gu32;
#define RLX_AGENT __ATOMIC_RELAXED, __HIP_MEMORY_SCOPE_AGENT
#define LDS_WAIT() asm volatile("s_waitcnt lgkmcnt(0)" ::: "memory")
#define VM_WAIT() asm volatile("s_waitcnt vmcnt(0)" ::: "memory")
typedef float f32x2_ __attribute__((ext_vector_type(2)));
typedef __bf16 bf16x2_ __attribute__((ext_vector_type(2)));
__device__ __forceinline__ unsigned pk2(float lo, float hi) { const f32x2_ v = {lo, hi}; const bf16x2_ b = __builtin_convertvector(v, bf16x2_); return __builtin_bit_cast(unsigned, b); }
__device__ __forceinline__ float bflo(unsigned w) { return __uint_as_float(w << 16); }
__device__ __forceinline__ float bfhi(unsigned w) { return __uint_as_float(w & 0xffff0000u); }
__device__ __forceinline__ float sigmoidf_(float x) { return __builtin_amdgcn_rcpf(1.0f + __expf(-x)); }
__device__ __forceinline__ float wave_sum(float v) {
#pragma unroll
    for (int o = 1; o < 64; o <<= 1) v += __shfl_xor(v, o);
    return v;
}
__device__ __forceinline__ unsigned pk4_fp8(float a, float b, float c, float d) { int w = __builtin_amdgcn_cvt_pk_fp8_f32(a, b, 0, false); w = __builtin_amdgcn_cvt_pk_fp8_f32(c, d, w, true); return (unsigned)w; }
constexpr float W8_SCALE = 64.0f, W8_INV = 1.0f / 64.0f;
#define XB_TMO      128
#define XB_XCNT(j)  (256  + 64 * (j))
#define XB_XSUB(j)  (1280 + 64 * (j))
#define XB_XGEN(j)  (2304 + 64 * (j))
#define XB_TOP      3328
#define XB_TOPGEN   3392
#define XCD_BAR_WORDS 3456
#define XB_SPIN_CAP (1u << 18)

__device__ __forceinline__ unsigned xb_ld(unsigned* p)              { return __hip_atomic_load(p, __ATOMIC_RELAXED, __HIP_MEMORY_SCOPE_AGENT); }
__device__ __forceinline__ unsigned xb_add(unsigned* p, unsigned v) { return __hip_atomic_fetch_add(p, v, __ATOMIC_RELAXED, __HIP_MEMORY_SCOPE_AGENT); }
__device__ __forceinline__ unsigned xb_xcc_id() { return (unsigned)__builtin_amdgcn_s_getreg((3 << 11) | 20) & 0xFu; }
#define XB_SPIN(cond, bar) do { unsigned _sp = 0; while (cond) { __builtin_amdgcn_s_sleep(1); \
    if ((++_sp & 255u) == 0u) { if (xb_ld(&(bar)[XB_TMO])) break; if (_sp > XB_SPIN_CAP) { atomicAdd(&(bar)[XB_TMO], 1u); break; } } } } while (0)

struct XcdBarrier {
    unsigned* bar; unsigned x;
    volatile LAS unsigned* st;
};

__device__ __forceinline__ XcdBarrier xcd_barrier_post(unsigned* bar, volatile LAS unsigned* st) {
    XcdBarrier b; b.bar = bar; b.x = xb_xcc_id(); b.st = st;
    if (threadIdx.x == 0) (void)xb_add(&bar[XB_XCNT(b.x)], 1u);
    return b;
}
__device__ __forceinline__ void xcd_barrier_complete(unsigned* bar, unsigned x, unsigned& nloc, unsigned& nx) {
    const unsigned G = gridDim.x * gridDim.y * gridDim.z;
    unsigned sum, cnt, mine, sp = 0u;
    for (;;) {
        sum = 0u; cnt = 0u; mine = 0u;
#pragma unroll
        for (unsigned j = 0; j < 16; ++j) { const unsigned c = xb_ld(&bar[XB_XCNT(j)]); sum += c; cnt += (c > 0u) ? 1u : 0u; mine = (j == x) ? c : mine; }
        if (sum == G) break;
        __builtin_amdgcn_s_sleep(1);
        if ((++sp & 255u) == 0u) { if (xb_ld(&bar[XB_TMO])) break; if (sp > XB_SPIN_CAP) { atomicAdd(&bar[XB_TMO], 1u); break; } }
    }
    nloc = mine > 0u ? mine : 1u; nx = cnt > 0u ? cnt : 1u;
}

__device__ __forceinline__ void xcd_barrier(const XcdBarrier& b) {
    asm volatile("s_waitcnt vmcnt(0)" ::: "memory");
    __syncthreads();
    if (threadIdx.x == 0) {
        unsigned* bar = b.bar;
        __builtin_amdgcn_s_waitcnt(0);
        unsigned nloc = b.st[0], nx = b.st[1];
        if (nloc == 0u) { xcd_barrier_complete(bar, b.x, nloc, nx); b.st[0] = nloc; b.st[1] = nx; }
        const unsigned old = xb_add(&bar[XB_XSUB(b.x)], 1u);
        const unsigned gen = old / nloc;
        if (old + 1u == (gen + 1u) * nloc) {
            __builtin_amdgcn_fence(__ATOMIC_RELEASE, "agent");
            asm volatile("s_waitcnt vmcnt(0)" ::: "memory");
            const unsigned og = xb_add(&bar[XB_TOP], 1u);
            const unsigned tg = og / nx;
            if (og + 1u == (tg + 1u) * nx) xb_add(&bar[XB_TOPGEN], 1u);
            else XB_SPIN(xb_ld(&bar[XB_TOPGEN]) == tg, bar);
            __builtin_amdgcn_fence(__ATOMIC_ACQUIRE, "agent");
            xb_add(&bar[XB_XGEN(b.x)], 1u);
            asm volatile("s_waitcnt vmcnt(0)" ::: "memory");
        } else {
            XB_SPIN(xb_ld(&bar[XB_XGEN(b.x)]) == gen, bar);
            __builtin_amdgcn_fence(__ATOMIC_ACQUIRE, "agent");
            asm volatile("s_waitcnt vmcnt(0)" ::: "memory");
        }
    }
    __syncthreads();
}

namespace blk {
using pg8::Unit; using pg8::f32x4; using pg8::u32x4; using pg8::bf16_t;
typedef float f32x4_t __attribute__((ext_vector_type(4)));

struct SchedP1 {
    pg8::StaticOrder so;
    __device__ __forceinline__ void init(int G, int c) { so.init(T, NIN, G, c); }
    __device__ __forceinline__ bool next(int i, Unit& u) const {
        const long L = (long)i * so.G + so.c;
        constexpr int MA = (int)(WS_H0B / MiB), MB = (int)(WS_BT1 / MiB);
        if (L < so.nwg) { if (!so.next(i, u)) return false; u.rm = u.pm; u.rn = u.pn; u.pm += MA; u.pn += MB; return true; }
        const int j = (int)(L - so.nwg); if (j >= 32) return false;
        if (j < 16) { const int mb = j & 1, ct = j >> 1; u.pm = MA + 32 + mb; u.pn = MB + 33 + ct; u.rm = mb; u.rn = 64 + ct; }
        else { const int jj = j - 16, dt = jj >> 1, mb = jj & 1; u.pm = MB + 33 + 8 + dt; u.pn = MA + 32 + mb; u.rm = dt; u.rn = 128 + mb; }
        return true;
    }
    __device__ __forceinline__ void a_ready(const Unit&) const {}
    __device__ __forceinline__ void done(const Unit&) const {}
};
struct EpiProj {
    static constexpr bool PERM = true, AFTER_DRAIN = false;
    unsigned char* ws; const float* bias;
    __device__ __forceinline__ void operator()(const f32x4 (&acc)[2][2][4][2], const Unit& u, int wr, int wc, int fr, int fq) const {
        const int kind = u.rn >> 6; const bool mn = kind == 0;
        bf16_t* base = (bf16_t*)(ws + WS_PROJ + (size_t)(kind >= 1) * (WS_KMEM - WS_PROJ) + (size_t)(kind >= 2) * (WS_VT - WS_KMEM)); const int ldc = 512 + (kind <= 1) * 1536 + (kind == 0) * (NIN - 2048);
        const int row0 = u.rm * 256 + wr * 64 + fr, col0 = (u.rn & 63) * 256 + wc * 32 + 8 * fq;
        f32x4 bv[2][2];
#pragma unroll
        for (int bj = 0; bj < 2; ++bj)
#pragma unroll
            for (int n = 0; n < 2; ++n) bv[bj][n] = mn ? *(const f32x4*)(bias + col0 + bj * 128 + 4 * n) : (f32x4){0.f, 0.f, 0.f, 0.f};
#pragma unroll
        for (int ai = 0; ai < 2; ++ai)
#pragma unroll
            for (int m = 0; m < 4; ++m) { bf16_t* rowp = base + (size_t)(row0 + ai * 128 + m * 16) * ldc + col0;
#pragma unroll
                for (int bj = 0; bj < 2; ++bj) { const f32x4 v0 = acc[ai][bj][m][0] + bv[bj][0], v1 = acc[ai][bj][m][1] + bv[bj][1];
                    u32x4 w; w.x = pk2(v0[0], v0[1]); w.y = pk2(v0[2], v0[3]); w.z = pk2(v1[0], v1[1]); w.w = pk2(v1[2], v1[3]);
                    *(u32x4*)(rowp + bj * 128) = w; } }
    }
};
struct EpiBf16B {
    static constexpr bool PERM = true, AFTER_DRAIN = false;
    bf16_t* O; int ldc; const float* bias; int cmask, cshift, bstride; float scale;
    __device__ __forceinline__ void operator()(const f32x4 (&acc)[2][2][4][2], const Unit& u, int wr, int wc, int fr, int fq) const {
        const int row0 = u.pm * 256 + wr * 64 + fr, col0 = (u.pn & cmask) * 256 + wc * 32 + 8 * fq;
        const float* bp = bias ? bias + (size_t)(u.pn >> cshift) * bstride + col0 : nullptr;
        f32x4 bv[2][2];
#pragma unroll
        for (int bj = 0; bj < 2; ++bj)
#pragma unroll
            for (int n = 0; n < 2; ++n) bv[bj][n] = bp ? *(const f32x4*)(bp + bj * 128 + 4 * n) : (f32x4){0.f, 0.f, 0.f, 0.f};
#pragma unroll
        for (int ai = 0; ai < 2; ++ai)
#pragma unroll
            for (int m = 0; m < 4; ++m) { bf16_t* rowp = O + (size_t)(row0 + ai * 128 + m * 16) * ldc + col0;
#pragma unroll
                for (int bj = 0; bj < 2; ++bj) { const f32x4 v0 = acc[ai][bj][m][0] * scale + bv[bj][0], v1 = acc[ai][bj][m][1] * scale + bv[bj][1];
                    u32x4 w; w.x = pk2(v0[0], v0[1]); w.y = pk2(v0[2], v0[3]); w.z = pk2(v1[0], v1[1]); w.w = pk2(v1[2], v1[3]);
                    *(u32x4*)(rowp + bj * 128) = w; } }
    }
};
struct EpiGate {
    static constexpr bool PERM = true, AFTER_DRAIN = false;
    const bf16_t* proj; bf16_t* gg;
    __device__ __forceinline__ static float em(float x) { return __expf(-x); }
    __device__ __forceinline__ void mid(f32x4 (&acc)[2][2][4][2], const Unit& u, int wr, int wc, int fr, int fq) const {
        int row0 = u.pm * 256 + wr * 64 + fr; const int col0 = u.pn * 256 + wc * 32 + 8 * fq;
        asm volatile("" : "+v"(row0));
#pragma unroll
        for (int ai = 0; ai < 2; ++ai)
#pragma unroll
            for (int m = 0; m < 4; ++m) { const size_t row = (size_t)(row0 + ai * 128 + m * 16);
#pragma unroll
                for (int bj = 0; bj < 2; ++bj) {
                    const u32x4 ga = *(const u32x4*)(proj + row * NIN + C_GA + col0 + bj * 128), gb = *(const u32x4*)(proj + row * NIN + C_GB + col0 + bj * 128);
                    const unsigned gaw[4] = {ga.x, ga.y, ga.z, ga.w}, gbw[4] = {gb.x, gb.y, gb.z, gb.w};
#pragma unroll
                    for (int q = 0; q < 4; ++q) {
                        const float r0 = (1.0f + em(fmaxf(bflo(gbw[q]), -60.0f))) * __builtin_amdgcn_rcpf(1.0f + em(bflo(gaw[q]))), r1 = (1.0f + em(fmaxf(bfhi(gbw[q]), -60.0f))) * __builtin_amdgcn_rcpf(1.0f + em(bfhi(gaw[q])));
                        acc[ai][bj][m][q >> 1][2 * (q & 1)] *= r0; acc[ai][bj][m][q >> 1][2 * (q & 1) + 1] *= r1; } }
                asm volatile("" ::: "memory"); }
    }
    __device__ __forceinline__ void operator()(const f32x4 (&acc)[2][2][4][2], const Unit& u, int wr, int wc, int fr, int fq) const {
        int row0 = u.pm * 256 + wr * 64 + fr; const int col0 = u.pn * 256 + wc * 32 + 8 * fq;
        asm volatile("" : "+v"(row0));
#pragma unroll
        for (int ai = 0; ai < 2; ++ai)
#pragma unroll
            for (int m = 0; m < 4; ++m) { const size_t row = (size_t)(row0 + ai * 128 + m * 16);
#pragma unroll
                for (int bj = 0; bj < 2; ++bj) {
                    const u32x4 gb = *(const u32x4*)(proj + row * NIN + C_GB + col0 + bj * 128);
                    const unsigned gbw[4] = {gb.x, gb.y, gb.z, gb.w}; float o[8];
#pragma unroll
                    for (int q = 0; q < 4; ++q) { o[2 * q] = acc[ai][bj][m][q >> 1][2 * (q & 1)] * __builtin_amdgcn_rcpf(1.0f + em(fmaxf(bflo(gbw[q]), -60.0f))); o[2 * q + 1] = acc[ai][bj][m][q >> 1][2 * (q & 1) + 1] * __builtin_amdgcn_rcpf(1.0f + em(fmaxf(bfhi(gbw[q]), -60.0f))); }
                    u32x4 w; w.x = pk2(o[0], o[1]); w.y = pk2(o[2], o[3]); w.z = pk2(o[4], o[5]); w.w = pk2(o[6], o[7]);
                    *(u32x4*)(gg + row * D + col0 + bj * 128) = w; } }
    }
};
struct EpiRes {
    static constexpr bool PERM = false, AFTER_DRAIN = false;
    const float* res; float* out;
    __device__ __forceinline__ void operator()(const f32x4 (&acc)[2][2][4][2], const Unit& u, int wr, int wc, int fr, int fq) const {
        const int row0 = u.pm * 256 + wr * 64 + fr, col0 = u.pn * 256 + wc * 32 + 4 * fq;
#pragma unroll
        for (int ai = 0; ai < 2; ++ai)
#pragma unroll
            for (int m = 0; m < 4; ++m) { const size_t off = (size_t)(row0 + ai * 128 + m * 16) * D + col0;
#pragma unroll
                for (int bj = 0; bj < 2; ++bj)
#pragma unroll
                    for (int n = 0; n < 2; ++n) { const f32x4 r = *(const f32x4*)(res + off + bj * 128 + n * 16);
                        *(f32x4*)(out + off + bj * 128 + n * 16) = r * ALPHA + acc[ai][bj][m][n]; } }
    }
};
struct SchedMoE {
    static constexpr int RT_LDS = 12;
    const PG8_LAS int* mine; const PG8_LAS int* rts; const int* rowtok; int n;
    __device__ __forceinline__ void init(const int* tab, int nN, int G, int c, PG8_LAS int* lds_list, int tid, const int* rowtok_ = nullptr) {
        const int nwg = tab[192] * nN; const int* ul = tab + (nN == 16 ? 1024 : 8192);
        n = c < nwg ? (nwg - c + G - 1) / G : 0;
        if (tid < n && tid < 256) lds_list[tid] = ul[tid * G + c];
        rowtok = rowtok_; PG8_LAS int* r = lds_list + 256;
        if (rowtok_) { for (int i = 0; i < n && i < RT_LDS; ++i) { const int pm = ul[i * G + c] & 0xffff; if (tid < 256) r[i * 256 + tid] = rowtok_[pm * 256 + tid]; } }
        __syncthreads();
        mine = lds_list; rts = r;
    }
    __device__ __forceinline__ bool next(int i, Unit& u) const {
        if (i >= n) return false;
        const int x = mine[i]; u.pm = x & 0xffff; u.pn = x >> 16; u.rm = 0; u.rn = 0; return true;
    }
    __device__ __forceinline__ int row_of(int i, int r) const { return i < RT_LDS ? rts[i * 256 + r] : rowtok[(mine[i] & 0xffff) * 256 + r]; }
    __device__ __forceinline__ void a_ready(const Unit&) const {}
    __device__ __forceinline__ void done(const Unit&) const {}
};
struct EpiSwiGLU {
    static constexpr bool PERM = true, AFTER_DRAIN = false;
    unsigned char* act; const float* b_up;
    __device__ __forceinline__ void operator()(const f32x4 (&acc)[2][2][4][2], const Unit& u, int wr, int wc, int fr, int fq) const {
        const int e = u.pn >> 4, ct = u.pn & 15;
        const int row0 = u.pm * 256 + wr * 64 + fr, c8 = ct * 128 + wc * 32 + 8 * fq;
        f32x4 bg[2], bl[2];
#pragma unroll
        for (int n = 0; n < 2; ++n) { bg[n] = *(const f32x4*)(b_up + (size_t)e * 4096 + c8 + 4 * n); bl[n] = *(const f32x4*)(b_up + (size_t)e * 4096 + 2048 + c8 + 4 * n); }
#pragma unroll
        for (int ai = 0; ai < 2; ++ai)
#pragma unroll
            for (int m = 0; m < 4; ++m) { unsigned char* rowp = act + (size_t)(row0 + ai * 128 + m * 16) * FF + c8;
                float a[8];
#pragma unroll
                for (int n = 0; n < 2; ++n) { const f32x4 g = acc[ai][0][m][n] * W8_INV + bg[n], l = acc[ai][1][m][n] * W8_INV + bl[n];
#pragma unroll
                    for (int j = 0; j < 4; ++j) { const float gl = fminf(g[j], 7.0f), li = fminf(fmaxf(l[j], -7.0f), 7.0f);
                        a[4 * n + j] = gl * sigmoidf_(1.702f * gl) * (li + 1.0f); } }
                v2u w; w.x = pk4_fp8(a[0], a[1], a[2], a[3]); w.y = pk4_fp8(a[4], a[5], a[6], a[7]);
                *(v2u*)rowp = w; }
    }
};
}

struct Frame {
    LAS unsigned char* lds;
    volatile LAS unsigned* MISC;
    gu32* ctl;
    int tid, lane, wave, vcu, G;
    const float* const* in; float* out; unsigned char* ws;
};
#define WSP(type, off) ((type*)(F.ws + (off)))

#ifndef CVT_HASH
#define CVT_HASH 0
#endif
struct CvtMat { const float* W; void* WT; int K, N, drow_base, upperm, total, pitch, koff; };
constexpr int CVT_LP16 = 4;
constexpr int CVT_LP8 = 3;
template <bool FP8> __device__ __forceinline__ void cvt_addr(const CvtMat& M, int it_, const float*& src, unsigned char*& dst) {
    int it = it_;
    constexpr int LP = FP8 ? CVT_LP8 : CVT_LP16, KTS = 10 - LP, NTS = 2 + LP;
    if (FP8 && CVT_HASH) it = (int)(((unsigned)it * 40503u) & (unsigned)(M.total - 1));
    const int nblk = M.N >> NTS, per_e = (M.K >> KTS) * nblk, e = it / per_e, r = it - e * per_e, kb = r / nblk, nb = r - kb * nblk, n0 = nb << NTS;
    int drow = M.drow_base + n0;
    if (M.upperm) { const int half = n0 >= 2048 ? 1 : 0, nn = n0 - half * 2048; drow = (nn >> 7) * 256 + half * 128 + (nn & 127); }
    src = M.W + ((size_t)e * M.K + (kb << KTS)) * M.N + n0;
    dst = (unsigned char*)M.WT + (((size_t)e * M.N + drow) * M.pitch + M.koff + (kb << KTS)) * (FP8 ? 1 : 2);
}
__device__ __forceinline__ void tr_load(f32x4 (&v)[16], const float* src, int N, unsigned loff) {
    const unsigned long long base = (unsigned long long)src;
    const unsigned blo = __builtin_amdgcn_readfirstlane((unsigned)base), bhi = __builtin_amdgcn_readfirstlane((unsigned)(base >> 32));
    const unsigned long long ub = ((unsigned long long)bhi << 32) | blo; const unsigned long long rstep = (unsigned long long)(unsigned)N * 4ull;
#pragma unroll
    for (int i = 0; i < 16; ++i) { const unsigned long long rb = ub + (unsigned long long)i * rstep;
        asm volatile("global_load_dwordx4 %0, %1, %2 nt" : "=&v"(v[i]) : "v"(loff), "s"(rb) : "memory"); }
}
template <int NYOUNG> __device__ __forceinline__ void tr_wait(f32x4 (&v)[16]) {
    asm volatile("s_waitcnt vmcnt(%16)" : "+v"(v[0]), "+v"(v[1]), "+v"(v[2]), "+v"(v[3]), "+v"(v[4]), "+v"(v[5]), "+v"(v[6]), "+v"(v[7]), "+v"(v[8]), "+v"(v[9]), "+v"(v[10]), "+v"(v[11]), "+v"(v[12]), "+v"(v[13]), "+v"(v[14]), "+v"(v[15]) : "n"(NYOUNG) : "memory");
}
__device__ __forceinline__ void tr_store(const f32x4 (&v)[16], unsigned char* dst8, int K, int lane) {
    bf16* d0 = (bf16*)dst8 + (size_t)(4 * (lane & ((1 << CVT_LP16) - 1))) * K + 16 * (lane >> CVT_LP16);
#pragma unroll
    for (int j = 0; j < 4; ++j) {
        v4u lo, hi;
        lo.x = pk2(v[0][j], v[1][j]); lo.y = pk2(v[2][j], v[3][j]); lo.z = pk2(v[4][j], v[5][j]); lo.w = pk2(v[6][j], v[7][j]);
        hi.x = pk2(v[8][j], v[9][j]); hi.y = pk2(v[10][j], v[11][j]); hi.z = pk2(v[12][j], v[13][j]); hi.w = pk2(v[14][j], v[15][j]);
        bf16* d = d0 + (size_t)j * K;
        *(v4u*)d = lo; *(v4u*)(d + 8) = hi;
    }
}
__device__ __forceinline__ void tr_store_fp8(const f32x4 (&v)[16], unsigned char* dst8, int K, int lane) {
    unsigned char* d0 = dst8 + (size_t)(4 * (lane & ((1 << CVT_LP8) - 1))) * K + 16 * (lane >> CVT_LP8);
#pragma unroll
    for (int j = 0; j < 4; ++j) {
        v4u o;
        o.x = pk4_fp8(v[0][j] * W8_SCALE, v[1][j] * W8_SCALE, v[2][j] * W8_SCALE, v[3][j] * W8_SCALE); o.y = pk4_fp8(v[4][j] * W8_SCALE, v[5][j] * W8_SCALE, v[6][j] * W8_SCALE, v[7][j] * W8_SCALE);
        o.z = pk4_fp8(v[8][j] * W8_SCALE, v[9][j] * W8_SCALE, v[10][j] * W8_SCALE, v[11][j] * W8_SCALE); o.w = pk4_fp8(v[12][j] * W8_SCALE, v[13][j] * W8_SCALE, v[14][j] * W8_SCALE, v[15][j] * W8_SCALE);
        __builtin_nontemporal_store(o, (v4u*)(d0 + (size_t)j * K));
    }
}
template <bool FP8> __device__ __forceinline__ void convert_mat(const CvtMat& M, int total, int wi, int nw, int lane) {
    constexpr int LP = FP8 ? CVT_LP8 : CVT_LP16;
    const unsigned loff = (unsigned)((16 * (lane >> LP)) * M.N + 4 * (lane & ((1 << LP) - 1))) * 4u;
    int it = wi;
    if constexpr (FP8) {
        for (; it + nw < total; it += 2 * nw) {
            const float* s0; const float* s1; unsigned char* d0; unsigned char* d1;
            cvt_addr<FP8>(M, it, s0, d0); cvt_addr<FP8>(M, it + nw, s1, d1);
            f32x4 v0[16], v1[16];
            tr_load(v0, s0, M.N, loff); tr_load(v1, s1, M.N, loff);
            tr_wait<16>(v0); tr_store_fp8(v0, d0, M.pitch, lane);
            tr_wait<0>(v1); tr_store_fp8(v1, d1, M.pitch, lane);
        }
    }
    if constexpr (!FP8)
    for (; it + 2 * nw < total; it += 3 * nw) {
        const float* s0; const float* s1; const float* s2; unsigned char* d0; unsigned char* d1; unsigned char* d2;
        cvt_addr<FP8>(M, it, s0, d0); cvt_addr<FP8>(M, it + nw, s1, d1); cvt_addr<FP8>(M, it + 2 * nw, s2, d2);
        f32x4 v0[16], v1[16], v2[16];
        tr_load(v0, s0, M.N, loff); tr_load(v1, s1, M.N, loff); tr_load(v2, s2, M.N, loff);
        tr_wait<32>(v0); if (FP8) tr_store_fp8(v0, d0, M.pitch, lane); else tr_store(v0, d0, M.pitch, lane);
        tr_wait<16>(v1); if (FP8) tr_store_fp8(v1, d1, M.pitch, lane); else tr_store(v1, d1, M.pitch, lane);
        tr_wait<0>(v2); if (FP8) tr_store_fp8(v2, d2, M.pitch, lane); else tr_store(v2, d2, M.pitch, lane);
    }
    for (; it < total; it += nw) {
        const float* s0; unsigned char* d0; cvt_addr<FP8>(M, it, s0, d0);
        f32x4 v0[16]; tr_load(v0, s0, M.N, loff); tr_wait<0>(v0); if (FP8) tr_store_fp8(v0, d0, M.pitch, lane); else tr_store(v0, d0, M.pitch, lane);
    }
}
__device__ __forceinline__ void ln_row(f32x4 (&v)[8], const float* g, const float* b, int lane) {
    float s = 0.f;
#pragma unroll
    for (int j = 0; j < 8; ++j) s += (v[j][0] + v[j][1]) + (v[j][2] + v[j][3]);
    const float mean = wave_sum(s) * (1.f / D);
    float s2 = 0.f;
#pragma unroll
    for (int j = 0; j < 8; ++j) { v[j] = v[j] - mean; s2 += (v[j][0] * v[j][0] + v[j][1] * v[j][1]) + (v[j][2] * v[j][2] + v[j][3] * v[j][3]); }
    const float rstd = 1.0f / sqrtf(wave_sum(s2) * (1.f / D) + LN_EPS);
#pragma unroll
    for (int j = 0; j < 8; ++j) { const f32x4 gg = ((const f32x4*)g)[lane + 64 * j], bb = ((const f32x4*)b)[lane + 64 * j]; v[j] = v[j] * rstd * gg + bb; }
}
__device__ __forceinline__ void row_load(f32x4 (&v)[8], const float* p, int lane) {
#pragma unroll
    for (int j = 0; j < 8; ++j) v[j] = ((const f32x4*)p)[lane + 64 * j];
}
__device__ __forceinline__ void row_store_f32(const f32x4 (&v)[8], float* p, int lane) {
#pragma unroll
    for (int j = 0; j < 8; ++j) ((f32x4*)p)[lane + 64 * j] = v[j];
}
__device__ __forceinline__ void row_store_bf16(const f32x4 (&v)[8], bf16* p, int lane) {
#pragma unroll
    for (int j = 0; j < 8; ++j) { v2u w; w.x = pk2(v[j][0], v[j][1]); w.y = pk2(v[j][2], v[j][3]); ((v2u*)p)[lane + 64 * j] = w; }
}

__device__ __forceinline__ void p0_prologue(Frame& F) {
    const int gw = F.vcu * NWAVES + F.wave, NGW = F.G * NWAVES;
    { const CvtMat M{F.in[5], WSP(bf16, WS_BT1), 2048, NIN, 0, 0, 32 * 132, 2048, 0}; convert_mat<false>(M, 32 * 132, gw, NGW, F.lane); }
    { const CvtMat M{F.in[14], WSP(bf16, WS_BT1), 2048, 4096, NIN, 0, 32 * 64, 2048, 0}; convert_mat<false>(M, 32 * 64, gw, NGW, F.lane); }
    for (int m = gw; m < T; m += NGW) {
        f32x4 v[8]; row_load(v, F.in[0] + (size_t)m * D, F.lane);
        ln_row(v, F.in[2], F.in[3], F.lane);
        row_store_f32(v, WSP(float, WS_H0F) + (size_t)m * D, F.lane);
        row_store_bf16(v, WSP(bf16, WS_H0B) + (size_t)m * D, F.lane);
    }
    for (int m = gw; m < NB * MEMLEN; m += NGW) {
        f32x4 v[8]; row_load(v, F.in[1] + (size_t)m * D, F.lane);
        row_store_bf16(v, WSP(bf16, WS_H0B) + (size_t)(T + m) * D, F.lane);
    }
}

__device__ __forceinline__ void cvt_role_p1(Frame& F, int wi, int nw) {
    { const CvtMat M{F.in[8], WSP(bf16, WS_BTAB), 1024, 2048, 0, 0, 16 * 32, 2048, 0}; convert_mat<false>(M, 16 * 32, wi, nw, F.lane); }
    { const CvtMat M{F.in[9], WSP(bf16, WS_BTAB), 1024, 2048, 0, 0, 16 * 32, 2048, 1024}; convert_mat<false>(M, 16 * 32, wi, nw, F.lane); }
    { const CvtMat M{F.in[10], WSP(bf16, WS_BTMIX), 2048, 2048, 0, 0, 32 * 32, 2048, 0}; convert_mat<false>(M, 32 * 32, wi, nw, F.lane); }
    { const CvtMat M{F.in[13], WSP(bf16, WS_BTXQ), 2048, 2048, 0, 0, 32 * 32, 2048, 0}; convert_mat<false>(M, 32 * 32, wi, nw, F.lane); }
    { const CvtMat M{F.in[15], WSP(bf16, WS_BTXO), 2048, 2048, 0, 0, 32 * 32, 2048, 0}; convert_mat<false>(M, 32 * 32, wi, nw, F.lane); }
    { const CvtMat M{F.in[20], WSP(bf16, WS_BTUP), 2048, 4096, 0, 1, NE * 32 * 64, 2048, 0}; convert_mat<true>(M, NE * 32 * 64, wi, nw, F.lane); }
    { const CvtMat M{F.in[22], WSP(bf16, WS_BTDN), 2048, 2048, 0, 0, NE * 32 * 32, 2048, 0}; convert_mat<true>(M, NE * 32 * 32, wi, nw, F.lane); }
}
__device__ __forceinline__ void cvt_role_p11(Frame& F, int wi, int nw) {
    const CvtMat M{F.in[22], WSP(bf16, WS_BTDN), 2048, 2048, 0, 0, NE * 32 * 32, 2048, 0}; convert_mat<true>(M, NE * 32 * 32, wi, nw, F.lane);
}
__device__ __forceinline__ int t5_bucket(int rel) {
    const int n = rel < 0 ? -rel : rel, base = rel > 0 ? 16 : 0;
    const int large = 8 + (n >= 12) + (n >= 16) + (n >= 23) + (n >= 32) + (n >= 46) + (n >= 64) + (n >= 91);
    return base + (n < 8 ? n : large);
}
__device__ __forceinline__ void load_row64(float (&q)[64], const bf16* p, float scale) {
#pragma unroll
    for (int i = 0; i < 8; ++i) { const v4u w = ((const v4u*)p)[i];
        q[8 * i + 0] = bflo(w.x) * scale; q[8 * i + 1] = bfhi(w.x) * scale; q[8 * i + 2] = bflo(w.y) * scale; q[8 * i + 3] = bfhi(w.y) * scale;
        q[8 * i + 4] = bflo(w.z) * scale; q[8 * i + 5] = bfhi(w.z) * scale; q[8 * i + 6] = bflo(w.w) * scale; q[8 * i + 7] = bfhi(w.w) * scale; }
}
__device__ __forceinline__ float dot_row64(const float (&q)[64], const bf16* p) {
    float s0 = 0.f, s1 = 0.f;
#pragma unroll
    for (int i = 0; i < 8; ++i) { const v4u w = ((const v4u*)p)[i];
        s0 += q[8 * i + 0] * bflo(w.x); s1 += q[8 * i + 1] * bfhi(w.x); s0 += q[8 * i + 2] * bflo(w.y); s1 += q[8 * i + 3] * bfhi(w.y);
        s0 += q[8 * i + 4] * bflo(w.z); s1 += q[8 * i + 5] * bfhi(w.z); s0 += q[8 * i + 6] * bflo(w.w); s1 += q[8 * i + 7] * bfhi(w.w); }
    return s0 + s1;
}
__device__ __forceinline__ void axpy_row64(float (&o)[64], float a, float p, const bf16* vp) {
#pragma unroll
    for (int i = 0; i < 8; ++i) { const v4u w = ((const v4u*)vp)[i];
        o[8 * i + 0] = o[8 * i + 0] * a + p * bflo(w.x); o[8 * i + 1] = o[8 * i + 1] * a + p * bfhi(w.x); o[8 * i + 2] = o[8 * i + 2] * a + p * bflo(w.y); o[8 * i + 3] = o[8 * i + 3] * a + p * bfhi(w.y);
        o[8 * i + 4] = o[8 * i + 4] * a + p * bflo(w.z); o[8 * i + 5] = o[8 * i + 5] * a + p * bfhi(w.z); o[8 * i + 6] = o[8 * i + 6] * a + p * bflo(w.w); o[8 * i + 7] = o[8 * i + 7] * a + p * bfhi(w.w); }
}
__device__ __forceinline__ void store_row64(const float (&o)[64], float scale, bf16* p) {
#pragma unroll
    for (int i = 0; i < 8; ++i) { v4u w; w.x = pk2(o[8 * i] * scale, o[8 * i + 1] * scale); w.y = pk2(o[8 * i + 2] * scale, o[8 * i + 3] * scale); w.z = pk2(o[8 * i + 4] * scale, o[8 * i + 5] * scale); w.w = pk2(o[8 * i + 6] * scale, o[8 * i + 7] * scale);
        ((v4u*)p)[i] = w; }
}
typedef short bf16x8 __attribute__((ext_vector_type(8)));
typedef float f32x16 __attribute__((ext_vector_type(16)));
#define MFMA32(a, b, c) __builtin_amdgcn_mfma_f32_32x32x16_bf16((a), (b), (c), 0, 0, 0)
__device__ __forceinline__ void p7_cross_mfma(Frame& F) {
    const bf16* qx = WSP(bf16, WS_QX); const bf16* kmem = WSP(bf16, WS_KMEM); const bf16* vT = WSP(bf16, WS_VT); bf16* ox = WSP(bf16, WS_OX);
    LAS unsigned char* L = F.lds + RING_OFF;
    constexpr int P_OFF = 0, P_STRIDE = 528, KV_OFF = 128 * P_STRIDE, K_STRIDE = 144, V_STRIDE = 528, ST_OFF = KV_OFF + 256 * K_STRIDE;
    static_assert(ST_OFF + 2048 <= RING_BYTES && 64 * V_STRIDE <= 256 * K_STRIDE, "cross-attention LDS map");
    const int w = F.wave, qt = w & 3, kh = w >> 2, r = F.lane & 31, h = F.lane >> 5, tid = F.tid;
    const float c2 = 0.044194173824159216f * 1.4426950408889634f;
    for (int u = F.vcu; u < 256; u += F.G) {
        const int b = u >> 7, head = (u >> 5) & 3, qblk = u & 31; const size_t row0 = (size_t)b * SEQ + qblk * 128;
        const bf16* qrow = qx + (row0 + qt * 32 + r) * D + head * 512 + 8 * h;
        const bf16* kbase = kmem + (size_t)b * MEMLEN * 2048 + head * 512;
        f32x16 sacc[4];
#pragma unroll
        for (int kt = 0; kt < 4; ++kt)
#pragma unroll
            for (int i = 0; i < 16; ++i) sacc[kt][i] = 0.f;
        v4u kst[4]; bf16x8 qf[4], qn[4];
#pragma unroll
        for (int j = 0; j < 4; ++j) { const int p = tid + 512 * j; kst[j] = *(const v4u*)(kbase + (size_t)(p >> 3) * 2048 + (p & 7) * 8); }
#pragma unroll
        for (int s = 0; s < 4; ++s) qf[s] = *(const bf16x8*)(qrow + 16 * s);
        for (int c = 0; c < 8; ++c) {
#pragma unroll
            for (int j = 0; j < 4; ++j) { const int p = tid + 512 * j; *(LAS v4u*)(L + KV_OFF + (p >> 3) * K_STRIDE + (p & 7) * 16) = kst[j]; }
            __syncthreads();
            if (c < 7) {
#pragma unroll
                for (int j = 0; j < 4; ++j) { const int p = tid + 512 * j; kst[j] = *(const v4u*)(kbase + (size_t)(p >> 3) * 2048 + (c + 1) * 64 + (p & 7) * 8); }
#pragma unroll
                for (int s = 0; s < 4; ++s) qn[s] = *(const bf16x8*)(qrow + (c + 1) * 64 + 16 * s);
            }
#pragma unroll
            for (int s = 0; s < 4; ++s)
#pragma unroll
                for (int kt = 0; kt < 4; ++kt) { const bf16x8 kf = *(const LAS bf16x8*)(L + KV_OFF + (kh * 128 + kt * 32 + r) * K_STRIDE + (16 * s + 8 * h) * 2);
                    sacc[kt] = MFMA32(kf, qf[s], sacc[kt]); }
            __syncthreads();
#pragma unroll
            for (int s = 0; s < 4; ++s) qf[s] = qn[s];
        }
        LAS float* mx = (LAS float*)(L + ST_OFF); LAS float* ls = mx + 256;
        float mloc = -3.0e38f;
#pragma unroll
        for (int kt = 0; kt < 4; ++kt)
#pragma unroll
            for (int i = 0; i < 16; ++i) mloc = fmaxf(mloc, sacc[kt][i]);
        mloc = fmaxf(mloc, __shfl_xor(mloc, 32));
        if (h == 0) mx[kh * 128 + qt * 32 + r] = mloc;
        __syncthreads();
        const float m = fmaxf(mx[qt * 32 + r], mx[128 + qt * 32 + r]);
        float lsum = 0.f;
#pragma unroll
        for (int kt = 0; kt < 4; ++kt)
#pragma unroll
            for (int i = 0; i < 16; ++i) { const float p = __builtin_amdgcn_exp2f((sacc[kt][i] - m) * c2); sacc[kt][i] = p; lsum += p; }
        lsum += __shfl_xor(lsum, 32);
        if (h == 0) ls[kh * 128 + qt * 32 + r] = lsum;
        __syncthreads();
        const float inv = 1.0f / (ls[qt * 32 + r] + ls[128 + qt * 32 + r]);
#pragma unroll
        for (int kt = 0; kt < 4; ++kt)
#pragma unroll
            for (int g = 0; g < 4; ++g) { v2u wv; wv.x = pk2(sacc[kt][4 * g] * inv, sacc[kt][4 * g + 1] * inv); wv.y = pk2(sacc[kt][4 * g + 2] * inv, sacc[kt][4 * g + 3] * inv);
                *(LAS v2u*)(L + P_OFF + (qt * 32 + r) * P_STRIDE + (kh * 128 + kt * 32 + 8 * g + 4 * h) * 2) = wv; }
        __syncthreads();
        bf16x8 pf[16];
#pragma unroll
        for (int s = 0; s < 16; ++s) pf[s] = *(const LAS bf16x8*)(L + P_OFF + (qt * 32 + r) * P_STRIDE + (16 * s + 8 * h) * 2);
        const bf16* vbase = vT + (size_t)head * 512 * 512 + b * MEMLEN;
        v4u vst[4];
#pragma unroll
        for (int j = 0; j < 4; ++j) { const int p = tid + 512 * j, row = p >> 5; vst[j] = *(const v4u*)(vbase + (size_t)((row >> 5) * 256 + (row & 31)) * 512 + (p & 31) * 8); }
        for (int i = 0; i < 8; ++i) {
#pragma unroll
            for (int j = 0; j < 4; ++j) { const int p = tid + 512 * j; *(LAS v4u*)(L + KV_OFF + (p >> 5) * V_STRIDE + (p & 31) * 16) = vst[j]; }
            __syncthreads();
            if (i < 7) {
#pragma unroll
                for (int j = 0; j < 4; ++j) { const int p = tid + 512 * j, row = p >> 5; vst[j] = *(const v4u*)(vbase + (size_t)((row >> 5) * 256 + (i + 1) * 32 + (row & 31)) * 512 + (p & 31) * 8); }
            }
            f32x16 acc;
#pragma unroll
            for (int k = 0; k < 16; ++k) acc[k] = 0.f;
#pragma unroll
            for (int s = 0; s < 16; ++s) { const bf16x8 vf = *(const LAS bf16x8*)(L + KV_OFF + (kh * 32 + r) * V_STRIDE + (16 * s + 8 * h) * 2); acc = MFMA32(vf, pf[s], acc); }
            bf16* op = ox + (row0 + qt * 32 + r) * D + head * 512 + (kh * 8 + i) * 32 + 4 * h;
#pragma unroll
            for (int g = 0; g < 4; ++g) { v2u wv; wv.x = pk2(acc[4 * g], acc[4 * g + 1]); wv.y = pk2(acc[4 * g + 2], acc[4 * g + 3]); *(v2u*)(op + 8 * g) = wv; }
            __syncthreads();
        }
    }
}
__device__ __forceinline__ int crow16(int i, int hh) { return (i & 3) + 8 * (i >> 2) + 4 * hh; }
__device__ __forceinline__ bf16x8 pack8(const f32x16& x, int s) {
    v4u p; p.x = pk2(x[8 * s], x[8 * s + 1]); p.y = pk2(x[8 * s + 2], x[8 * s + 3]); p.z = pk2(x[8 * s + 4], x[8 * s + 5]); p.w = pk2(x[8 * s + 6], x[8 * s + 7]);
    return __builtin_bit_cast(bf16x8, p);
}
__device__ __forceinline__ bf16x8 vt_frag(const LAS unsigned char* p) {
    const v2u lo = *(const LAS v2u*)p, hi = *(const LAS v2u*)(p + 16); v4u w; w.x = lo.x; w.y = lo.y; w.z = hi.x; w.w = hi.y; return __builtin_bit_cast(bf16x8, w);
}
__device__ __forceinline__ void vt_scatter(LAS unsigned char* vt, int stride, int c16, int key, v4u w) {
    LAS unsigned short* p = (LAS unsigned short*)(vt + (c16 * 8) * stride + key * 2); const int st = stride / 2;
    p[0] = (unsigned short)w.x; p[st] = (unsigned short)(w.x >> 16); p[2 * st] = (unsigned short)w.y; p[3 * st] = (unsigned short)(w.y >> 16);
    p[4 * st] = (unsigned short)w.z; p[5 * st] = (unsigned short)(w.z >> 16); p[6 * st] = (unsigned short)w.w; p[7 * st] = (unsigned short)(w.w >> 16);
}
__device__ __forceinline__ void p2_swa_mfma(Frame& F, int uc, int uG) {
    const bf16* proj = WSP(bf16, WS_PROJ); bf16* oa = WSP(bf16, WS_OAB);
    const float* relb = F.in[4]; const float* sinks = F.in[7];
    LAS unsigned char* L = F.lds + RING_OFF;
    constexpr int K_OFF = 0, K_STRIDE = 144, VT_OFF = 192 * K_STRIDE, VT_STRIDE = 392, BT_OFF = VT_OFF + 64 * VT_STRIDE;
    static_assert(BT_OFF + 8 * 256 * 4 <= RING_BYTES && BT_OFF % 16 == 0, "swa LDS map");
    const int w = F.wave, r = F.lane & 31, hh = F.lane >> 5, tid = F.tid;
    for (int u = uc; u < 256; u += uG) {
        const int b = u >> 7, g = (u >> 6) & 1, c = u & 63, h = g * 8 + w;
        const int k_lo = (c >= 2 ? c - 2 : 0) * 64, nk = c * 64 + 64 - k_lo, nkt = nk >> 5;
        const bf16* kvbase = proj + ((size_t)b * SEQ + k_lo) * NIN + g * 64;
#pragma unroll
        for (int j = 0; j < 3; ++j) { const int p = tid + 512 * j;
            if (p < nk * 8) { const int key = p >> 3, c16 = p & 7; const bf16* src = kvbase + (size_t)key * NIN + c16 * 8;
                *(LAS v4u*)(L + K_OFF + key * K_STRIDE + c16 * 16) = *(const v4u*)(src + C_KA);
                vt_scatter(L + VT_OFF, VT_STRIDE, c16, key, *(const v4u*)(src + C_VA)); } }
        LAS float* tab = (LAS float*)(L + BT_OFF) + w * 256;
#pragma unroll
        for (int j = 0; j < 4; ++j) { const int idx = F.lane + 64 * j; if (idx < 255) tab[idx] = relb[t5_bucket(idx - 191) * 16 + h]; }
        __syncthreads();
        const float sink = sinks[h];
        const int ibase = k_lo - c * 64 + 191;
#pragma unroll 1
        for (int qt = 0; qt < 2; ++qt) {
            const size_t row = (size_t)b * SEQ + c * 64 + qt * 32 + r;
            bf16x8 qf[4];
#pragma unroll
            for (int s = 0; s < 4; ++s) qf[s] = *(const bf16x8*)(proj + row * NIN + C_QA + h * 64 + 16 * s + 8 * hh);
            f32x16 sacc[6];
#pragma unroll
            for (int kt = 0; kt < 6; ++kt)
#pragma unroll
                for (int i = 0; i < 16; ++i) sacc[kt][i] = 0.f;
#pragma unroll
            for (int kt = 0; kt < 6; ++kt) if (kt < nkt) {
#pragma unroll
                for (int s = 0; s < 4; ++s) { const bf16x8 kf = *(const LAS bf16x8*)(L + K_OFF + (kt * 32 + r) * K_STRIDE + (16 * s + 8 * hh) * 2); sacc[kt] = MFMA32(kf, qf[s], sacc[kt]); } }
            float m = sink;
#pragma unroll
            for (int kt = 0; kt < 6; ++kt) if (kt < nkt) {
#pragma unroll
                for (int i = 0; i < 16; ++i) { const float sv = sacc[kt][i] * 0.125f + tab[ibase + kt * 32 + crow16(i, hh) - qt * 32 - r]; sacc[kt][i] = sv; m = fmaxf(m, sv); } }
            m = fmaxf(m, __shfl_xor(m, 32));
            float lsum = 0.f;
#pragma unroll
            for (int kt = 0; kt < 6; ++kt) if (kt < nkt) {
#pragma unroll
                for (int i = 0; i < 16; ++i) { const float p = __expf(sacc[kt][i] - m); sacc[kt][i] = p; lsum += p; } }
            lsum += __shfl_xor(lsum, 32);
            const float inv = 1.0f / (lsum + __expf(sink - m));
            f32x16 oacc[2];
#pragma unroll
            for (int dt = 0; dt < 2; ++dt)
#pragma unroll
                for (int i = 0; i < 16; ++i) oacc[dt][i] = 0.f;
#pragma unroll
            for (int kt = 0; kt < 6; ++kt) if (kt < nkt) {
#pragma unroll
                for (int i = 0; i < 16; ++i) sacc[kt][i] *= inv;
#pragma unroll
                for (int s = 0; s < 2; ++s) { const bf16x8 pf = pack8(sacc[kt], s);
#pragma unroll
                    for (int dt = 0; dt < 2; ++dt) { const bf16x8 vf = vt_frag(L + VT_OFF + (dt * 32 + r) * VT_STRIDE + (kt * 32 + 16 * s + 4 * hh) * 2); oacc[dt] = MFMA32(vf, pf, oacc[dt]); } } }
            bf16* op = oa + row * 2048 + h * 64 + 4 * hh;
#pragma unroll
            for (int dt = 0; dt < 2; ++dt)
#pragma unroll
                for (int gq = 0; gq < 4; ++gq) { v2u wv; wv.x = pk2(oacc[dt][4 * gq], oacc[dt][4 * gq + 1]); wv.y = pk2(oacc[dt][4 * gq + 2], oacc[dt][4 * gq + 3]); *(v2u*)(op + dt * 32 + 8 * gq) = wv; }
        }
        __syncthreads();
    }
}
__device__ __forceinline__ void p2_sb_mfma(Frame& F, int uc, int uG) {
    const bf16* proj = WSP(bf16, WS_PROJ); bf16* ob = WSP(bf16, WS_OAB) + 1024;
    LAS unsigned char* L = F.lds + RING_OFF;
    constexpr int K_OFF = 0, K_STRIDE = 144, VT_OFF = 448 * K_STRIDE, VT_STRIDE = 904, FL_OFF = VT_OFF + 64 * VT_STRIDE;
    static_assert(FL_OFF + 64 <= RING_BYTES && VT_OFF % 16 == 0, "sb LDS map");
    const int w = F.wave, r = F.lane & 31, hh = F.lane >> 5, tid = F.tid;
    const float LOG2E = 1.4426950408889634f, LN2 = 0.6931471805599453f;
    for (int u = uc; u < 512; u += uG) {
        const int b = u >> 8, h = (u >> 4) & 15, qb = u & 15, q0 = qb * 256, tstart = q0 + 32 * w, t = tstart + r;
        const size_t row = (size_t)b * SEQ + t;
        bf16x8 qf[4];
#pragma unroll
        for (int s = 0; s < 4; ++s) qf[s] = *(const bf16x8*)(proj + row * NIN + C_QB + h * 64 + 16 * s + 8 * hh);
        f32x16 oacc[2];
#pragma unroll
        for (int dt = 0; dt < 2; ++dt)
#pragma unroll
            for (int i = 0; i < 16; ++i) oacc[dt][i] = 0.f;
        float R = 0.f; bool done = false;
        int whi = q0 + 256, wlo = q0 >= 192 ? q0 - 192 : 0;
        for (;;) {
            const int nk = whi - wlo; const bf16* kvbase = proj + ((size_t)b * SEQ + wlo) * NIN + h * 64;
#pragma unroll
            for (int j = 0; j < 7; ++j) { const int p = tid + 512 * j;
                if (p < nk * 8) { const int key = p >> 3, c16 = p & 7; const bf16* src = kvbase + (size_t)key * NIN + c16 * 8;
                    *(LAS v4u*)(L + K_OFF + key * K_STRIDE + c16 * 16) = *(const v4u*)(src + C_KB);
                    vt_scatter(L + VT_OFF, VT_STRIDE, c16, key, *(const v4u*)(src + C_VB)); } }
            __syncthreads();
            for (int kb = (whi - 32 < tstart ? whi - 32 : tstart); kb >= wlo && !done; kb -= 32) {
                const int kl = kb - wlo;
                f32x16 sacc;
#pragma unroll
                for (int i = 0; i < 16; ++i) sacc[i] = 0.f;
#pragma unroll
                for (int s = 0; s < 4; ++s) { const bf16x8 kf = *(const LAS bf16x8*)(L + K_OFF + (kl + r) * K_STRIDE + (16 * s + 8 * hh) * 2); sacc = MFMA32(kf, qf[s], sacc); }
                float sp[16];
#pragma unroll
                for (int i = 0; i < 16; ++i) { const float z = sacc[i] * 0.125f; const bool on = (kb + crow16(i, hh)) < t;
                    const float e = __builtin_amdgcn_exp2f(-fabsf(z) * LOG2E);
                    const float spv = fmaxf(z, 0.f) + LN2 * __builtin_amdgcn_logf(1.0f + e);
                    sp[i] = on ? spv : 0.f; sacc[i] = on ? z - spv : -1.0e30f; }
                float gs[4], ot[4];
#pragma unroll
                for (int gq = 0; gq < 4; ++gq) { gs[gq] = (sp[4 * gq] + sp[4 * gq + 1]) + (sp[4 * gq + 2] + sp[4 * gq + 3]); ot[gq] = __shfl_xor(gs[gq], 32); }
                const float ps3 = gs[3] + ot[3], ps2 = gs[2] + ot[2], ps1 = gs[1] + ot[1], ps0 = gs[0] + ot[0];
                float ge[4];
                ge[3] = (hh == 0 ? ot[3] : 0.f); ge[2] = (hh == 0 ? ot[2] : 0.f) + ps3; ge[1] = (hh == 0 ? ot[1] : 0.f) + ps3 + ps2; ge[0] = (hh == 0 ? ot[0] : 0.f) + ps3 + ps2 + ps1;
#pragma unroll
                for (int gq = 0; gq < 4; ++gq) {
                    const float base = R - ge[gq];
                    const float e3 = base, e2 = e3 - sp[4 * gq + 3], e1 = e2 - sp[4 * gq + 2], e0 = e1 - sp[4 * gq + 1];
                    sacc[4 * gq + 3] = __builtin_amdgcn_exp2f((sacc[4 * gq + 3] + e3) * LOG2E); sacc[4 * gq + 2] = __builtin_amdgcn_exp2f((sacc[4 * gq + 2] + e2) * LOG2E);
                    sacc[4 * gq + 1] = __builtin_amdgcn_exp2f((sacc[4 * gq + 1] + e1) * LOG2E); sacc[4 * gq] = __builtin_amdgcn_exp2f((sacc[4 * gq] + e0) * LOG2E); }
                R -= (ps0 + ps1) + (ps2 + ps3);
#pragma unroll
                for (int s = 0; s < 2; ++s) { const bf16x8 pf = pack8(sacc, s);
#pragma unroll
                    for (int dt = 0; dt < 2; ++dt) { const bf16x8 vf = vt_frag(L + VT_OFF + (dt * 32 + r) * VT_STRIDE + (kl + 16 * s + 4 * hh) * 2); oacc[dt] = MFMA32(vf, pf, oacc[dt]); } }
                done = __all(R < -104.0f);
            }
            LAS unsigned* fl = (LAS unsigned*)(L + FL_OFF);
            if (F.lane == 0) fl[w] = done ? 1u : 0u;
            __syncthreads();
            bool alld = true;
#pragma unroll
            for (int i = 0; i < 8; ++i) alld = alld && (fl[i] != 0u);
            __syncthreads();
            if (alld || wlo == 0) break;
            whi = wlo; wlo = whi >= 448 ? whi - 448 : 0;
        }
        bf16* op = ob + row * 2048 + h * 64 + 4 * hh;
#pragma unroll
        for (int dt = 0; dt < 2; ++dt)
#pragma unroll
            for (int gq = 0; gq < 4; ++gq) { v2u wv; wv.x = pk2(oacc[dt][4 * gq], oacc[dt][4 * gq + 1]); wv.y = pk2(oacc[dt][4 * gq + 2], oacc[dt][4 * gq + 3]); *(v2u*)(op + dt * 32 + 8 * gq) = wv; }
    }
}
__device__ __forceinline__ void p_ln(Frame& F, const float* src, const float* g, const float* b, float* dstf, bf16* dstb) {
    const int gw = F.vcu * NWAVES + F.wave, NGW = F.G * NWAVES;
    for (int m = gw; m < T; m += NGW) {
        f32x4 v[8]; row_load(v, src + (size_t)m * D, F.lane);
        ln_row(v, g, b, F.lane);
        row_store_f32(v, dstf + (size_t)m * D, F.lane);
        row_store_bf16(v, dstb + (size_t)m * D, F.lane);
    }
}
__device__ __forceinline__ void p9_ln_router(Frame& F) {
    const float* wr = F.in[18]; const float* br = F.in[19];
    int* tok_e = WSP(int, WS_ROUTE); float* tok_g = WSP(float, WS_ROUTE + 131072); int* tok_pos = WSP(int, WS_ROUTE + 262144);
    float* h2f = WSP(float, WS_H2F);
    LAS float* part = (LAS float*)(F.lds + RING_OFF);
    LAS unsigned* lcnt = (LAS unsigned*)(F.lds + RING_OFF + 32768); LAS unsigned* lbase = lcnt + 32; LAS unsigned* lpe = lcnt + 64;
    if (F.tid < 32) lcnt[F.tid] = 0u;
    __syncthreads();
    const int w = F.wave, e = F.lane & 31, hh = F.lane >> 5;
    for (int u = F.vcu; u < T / 32; u += F.G) {
        const int tok0 = u * 32;
#pragma unroll 1
        for (int q = 0; q < 4; ++q) { const int m = tok0 + 4 * w + q;
            f32x4 v[8]; row_load(v, WSP(float, WS_S1) + (size_t)m * D, F.lane);
            ln_row(v, F.in[16], F.in[17], F.lane);
            row_store_f32(v, h2f + (size_t)m * D, F.lane);
            row_store_bf16(v, WSP(bf16, WS_H2B) + (size_t)m * D, F.lane);
            { unsigned* o8 = WSP(unsigned, WS_XS) + (size_t)m * (D / 4);
#pragma unroll
              for (int j = 0; j < 8; ++j) o8[F.lane + 64 * j] = pk4_fp8(v[j][0], v[j][1], v[j][2], v[j][3]); } }
        __syncthreads();
        f32x16 acc;
#pragma unroll
        for (int i = 0; i < 16; ++i) acc[i] = 0.f;
        const float* ap = h2f + (size_t)(tok0 + e) * D + 256 * w + 4 * hh;
        const float* bp = wr + (size_t)(256 * w + 4 * hh) * NE + e;
#pragma unroll 4
        for (int m = 0; m < 32; ++m) { const f32x4 a4 = *(const f32x4*)(ap + 8 * m);
#pragma unroll
            for (int j = 0; j < 4; ++j) acc = __builtin_amdgcn_mfma_f32_32x32x2f32(a4[j], bp[(size_t)(8 * m + j) * NE], acc, 0, 0, 0); }
#pragma unroll
        for (int i = 0; i < 16; ++i) part[(w * 32 + crow16(i, hh)) * 32 + e] = acc[i];
        __syncthreads();
        const float bias = br[e];
#pragma unroll 1
        for (int q = 0; q < 4; ++q) { const int tl = 4 * w + q, m = tok0 + tl;
            float val = bias;
#pragma unroll
            for (int ww = 0; ww < 8; ++ww) val += part[(ww * 32 + tl) * 32 + e];
            float tv[4]; int ti[4];
#pragma unroll
            for (int p = 0; p < 4; ++p) {
                float bv = val; int bi = e;
#pragma unroll
                for (int off = 1; off < 32; off <<= 1) { const float ov = __shfl_xor(bv, off); const int oi = __shfl_xor(bi, off);
                    const bool take = (ov > bv) || (ov == bv && oi < bi); bv = take ? ov : bv; bi = take ? oi : bi; }
                tv[p] = bv; ti[p] = bi;
                val = (e == bi) ? -3.0e38f : val;
            }
            const float e1 = __expf(tv[1] - tv[0]), e2 = __expf(tv[2] - tv[0]), e3 = __expf(tv[3] - tv[0]);
            const float inv = 1.0f / (1.0f + e1 + e2 + e3);
            if (F.lane < 4) {
                const int my_e = F.lane == 0 ? ti[0] : F.lane == 1 ? ti[1] : F.lane == 2 ? ti[2] : ti[3];
                const float my_g = (F.lane == 0 ? 1.0f : F.lane == 1 ? e1 : F.lane == 2 ? e2 : e3) * inv;
                const unsigned lpos = __hip_atomic_fetch_add((LAS unsigned*)&lcnt[my_e], 1u, __ATOMIC_RELAXED, __HIP_MEMORY_SCOPE_WORKGROUP);
                tok_e[m * 4 + F.lane] = my_e; tok_g[m * 4 + F.lane] = my_g; lpe[tl * 4 + F.lane] = (unsigned)my_e | (lpos << 8);
            } }
        __syncthreads();
        if (F.tid < 32) { const unsigned c = lcnt[F.tid]; lbase[F.tid] = c ? __hip_atomic_fetch_add((unsigned*)(F.ctl + CW_CNT + 64 * F.tid), c, RLX_AGENT) : 0u; }
        __syncthreads();
        if (F.tid < 128) { const unsigned x = lpe[F.tid]; tok_pos[tok0 * 4 + F.tid] = (int)(lbase[x & 255u] + (x >> 8)); }
        if (F.tid < 32) lcnt[F.tid] = 0u;
        __syncthreads();
    }
}
__device__ __forceinline__ void p10_scatter(Frame& F) {
    const int gw = F.vcu * NWAVES + F.wave, NGW = F.G * NWAVES;
    LAS int* poff = (LAS int*)(F.lds + RING_OFF);
    int* tab = WSP(int, WS_TAB);
    LAS int* lc = poff + 40;
    if (F.tid < NE) lc[F.tid] = (int)__hip_atomic_load((unsigned*)(F.ctl + CW_CNT + 64 * F.tid), RLX_AGENT);
    __syncthreads();
    if (F.tid == 0) {
        int acc = 0;
        int nbig = 0, nsml = 0;
        for (int e = 0; e < NE; ++e) { const int c = lc[e]; poff[e] = acc;
            const int nt = (c + 255) >> 8;
            if (blockIdx.x == 0) for (int k = 0; k < nt; ++k) { const int t = (acc >> 8) + k; tab[t] = e;
                if (c - 256 * k > 128) tab[256 + nbig++] = t; else tab[448 + nsml++] = t; }
            acc += nt << 8; }
        poff[32] = acc;
        if (blockIdx.x == 0) { tab[192] = acc >> 8; tab[193] = nbig; for (int k = 0; k < nsml; ++k) tab[256 + nbig + k] = tab[448 + k]; }
    }
    __syncthreads();
    if (blockIdx.x == 0) {
        const int rt = poff[32] >> 8;
        for (int pass = 0; pass < 2; ++pass) { const int nN = pass ? 8 : 16, nwg = rt * nN; int* ul = tab + (pass ? 8192 : 1024);
            for (int L = F.tid; L < nwg; L += NWAVES * 64) {
                const int q = nwg / 8, r8 = nwg % 8, xcd = L % 8, off = L / 8; const int wgid = (xcd < r8 ? xcd * (q + 1) : r8 * (q + 1) + (xcd - r8) * q) + off;
                int e = 0;
                for (int k = 1; k < NE; ++k) e = (wgid >= (poff[k] >> 8) * nN) ? k : e;
                const int first = poff[e] >> 8, re = (poff[e + 1] >> 8) - first, local = wgid - first * nN;
                ul[L] = (first + local % re) | ((e * nN + local / re) << 16); } }
    }
    const int* tok_e = WSP(int, WS_ROUTE); const int* tok_pos = WSP(int, WS_ROUTE + 262144); int* tok_row = WSP(int, WS_ROUTE + 393216);
    int* rowtok = WSP(int, WS_XS + 32 * MiB);
    const int gt = F.vcu * NWAVES * 64 + F.tid, NT = F.G * NWAVES * 64;
    for (int p = gt; p < T * 4; p += NT) { const int e = tok_e[p], row = poff[e] + tok_pos[p]; tok_row[p] = row; rowtok[row] = p >> 2; }
    for (int e = 0; e < NE; ++e) { const int c0 = poff[e] + lc[e], c1 = poff[e + 1]; for (int r = c0 + gt; r < c1; r += NT) rowtok[r] = 0; }
    __syncthreads();
}
__device__ __forceinline__ void p13_combine(Frame& F) {
    const int gw = F.vcu * NWAVES + F.wave, NGW = F.G * NWAVES;
    const float* tok_g = WSP(float, WS_ROUTE + 131072); const int* tok_row = WSP(int, WS_ROUTE + 393216);
    const bf16* yr = WSP(bf16, WS_YR);
    for (int m = gw; m < T; m += NGW) {
        f32x4 v[8]; row_load(v, WSP(float, WS_H2F) + (size_t)m * D, F.lane);
#pragma unroll
        for (int j = 0; j < 8; ++j) v[j] = v[j] * ALPHA;
#pragma unroll
        for (int k = 0; k < 4; ++k) { const float g = tok_g[m * 4 + k]; const v2u* yp = (const v2u*)(yr + (size_t)tok_row[m * 4 + k] * D);
#pragma unroll
            for (int j = 0; j < 8; ++j) { const v2u w = yp[F.lane + 64 * j]; v[j][0] += g * bflo(w.x); v[j][1] += g * bfhi(w.x); v[j][2] += g * bflo(w.y); v[j][3] += g * bfhi(w.y); } }
        ln_row(v, F.in[24], F.in[25], F.lane);
        row_store_f32(v, F.out + (size_t)m * D, F.lane);
    }
}

struct Args { const float* in[26]; float* out; unsigned char* ws; int ph_lo, ph_hi; };
__global__ void __launch_bounds__(NWAVES * 64, 2) mk_fwd(Args args) {
    extern __shared__ __attribute__((aligned(16))) unsigned char lds[];
    Frame F;
    F.lds = (LAS unsigned char*)lds;
    F.MISC = (volatile LAS unsigned*)(F.lds + MISC_OFF);
    F.tid = threadIdx.x; F.lane = F.tid & 63; F.wave = __builtin_amdgcn_readfirstlane(F.tid >> 6);
    F.G = gridDim.x; { const int bx = blockIdx.x; F.vcu = (F.G % 8 == 0) ? (bx % 8) * (F.G / 8) + bx / 8 : bx; }
    F.ws = args.ws; F.out = args.out;
    F.in = args.in;
    F.ctl = (gu32*)(F.ws + WS_CTL);
    for (int u = F.tid; u < (LDS_BYTES - LDSCTL_OFF) / 4; u += NWAVES * 64) ((LAS unsigned*)(F.lds + LDSCTL_OFF))[u] = 0u;
    __syncthreads();
    const int lo = args.ph_lo, hi = args.ph_hi;
    const bool multi = (hi - lo) > 1;
    XcdBarrier bar; bar.bar = (unsigned*)(F.ctl + CW_BAR); bar.x = 0; bar.st = nullptr;
    if (multi) bar = xcd_barrier_post((unsigned*)(F.ctl + CW_BAR), F.MISC + 8);
#ifndef P1_CW
#define P1_CW 18
#endif
#ifndef P11_CW
#define P11_CW 28
#endif
#ifndef REPEAT_MASK
#define REPEAT_MASK 0u
#endif
#ifndef PHMASK
#define PHMASK 0xffffffffu
#endif
#define IN(k) ((((PHMASK) >> (k)) & 1u) && lo <= (k) && (k) < hi)
#define RUN(k, ...) do { if (IN(k)) __VA_ARGS__ if (((REPEAT_MASK >> (k)) & 1u) && IN(k)) __VA_ARGS__ } while (0);
#define SEAM(k) do { if (IN(k) && IN((k) + 1)) xcd_barrier(bar); } while (0)
    const int G = F.G, cidx = (int)blockIdx.x;

    RUN(0, { p0_prologue(F); }) SEAM(0);
    const int xi = cidx & 7, pi = cidx >> 3, per_x = G >> 3;
    RUN(1, {
        const bool split = (G % 8 == 0) && per_x > P1_CW;
        if (!split) { cvt_role_p1(F, F.vcu * NWAVES + F.wave, G * NWAVES); if (multi) xcd_barrier(bar); }
        if (!split || pi < P1_CW) {
            pg8::Gemm g{(const bf16*)F.ws, (const bf16*)F.ws, T + 512, NIN + 4096, D}; blk::SchedP1 S; S.init(split ? P1_CW * 8 : G, split ? pi * 8 + xi : cidx);
            blk::EpiProj E{F.ws, F.in[6]};
            pg8::gemm_phase<blk::EpiProj, blk::SchedP1, true, true>(F.lds + RING_OFF, g, S, E);
            if (split) {
                VM_WAIT(); __syncthreads();
                if (F.tid == 0) {
                    __builtin_amdgcn_fence(__ATOMIC_RELEASE, "agent"); VM_WAIT();
                    gu32* cnt = F.ctl + CW_SUB; const unsigned want = (unsigned)(P1_CW * 8);
                    __hip_atomic_fetch_add(cnt, 1u, RLX_AGENT);
                    unsigned sp = 0;
                    while (__hip_atomic_load(cnt, RLX_AGENT) < want) { __builtin_amdgcn_s_sleep(2);
                        if ((++sp & 255u) == 0u) { if (__hip_atomic_load(F.ctl + CW_TMO, RLX_AGENT)) break; if (sp > (1u << 20)) { __hip_atomic_store(F.ctl + CW_TMO, 1u, RLX_AGENT); break; } } }
                    __builtin_amdgcn_fence(__ATOMIC_ACQUIRE, "agent"); VM_WAIT();
                }
                __syncthreads();
                p2_swa_mfma(F, xi * P1_CW + pi, P1_CW * 8); p2_sb_mfma(F, xi * P1_CW + pi, P1_CW * 8);
            }
        } else cvt_role_p1(F, ((pi - P1_CW) * 8 + xi) * NWAVES + F.wave, (per_x - P1_CW) * 8 * NWAVES);
    }) SEAM(1);
    if (!((G % 8 == 0) && per_x > P1_CW)) { RUN(2, { p2_swa_mfma(F, F.vcu, G); p2_sb_mfma(F, F.vcu, G); }) SEAM(2); }
    RUN(3, {
        pg8::Gemm g{WSP(bf16, WS_OAB), WSP(bf16, WS_BTAB), T, D, D}; pg8::StaticOrder S; S.init(T, D, G, cidx);
        blk::EpiGate E{WSP(bf16, WS_PROJ), WSP(bf16, WS_GG)};
        pg8::gemm_phase<blk::EpiGate, pg8::StaticOrder, true, true, false, false, true>(F.lds + RING_OFF, g, S, E);
    }) SEAM(3);
    RUN(4, {
        pg8::Gemm g{WSP(bf16, WS_GG), WSP(bf16, WS_BTMIX), T, D, D}; pg8::StaticOrder S; S.init(T, D, G, cidx);
        blk::EpiRes E{WSP(float, WS_H0F), WSP(float, WS_S1)};
        pg8::gemm_phase<blk::EpiRes, pg8::StaticOrder, true, true>(F.lds + RING_OFF, g, S, E);
    }) SEAM(4);
    RUN(5, { p_ln(F, WSP(float, WS_S1), F.in[11], F.in[12], WSP(float, WS_H1F), WSP(bf16, WS_H1B)); }) SEAM(5);
    RUN(6, {
        pg8::Gemm g{WSP(bf16, WS_H1B), WSP(bf16, WS_BTXQ), T, D, D}; pg8::StaticOrder S; S.init(T, D, G, cidx);
        blk::EpiBf16B E{WSP(bf16, WS_QX), D, nullptr, 0x7fffffff, 31, 0, 1.0f};
        pg8::gemm_phase<blk::EpiBf16B, pg8::StaticOrder, true, true>(F.lds + RING_OFF, g, S, E);
    }) SEAM(6);
    RUN(7, { p7_cross_mfma(F); }) SEAM(7);
    RUN(8, {
        pg8::Gemm g{WSP(bf16, WS_OX), WSP(bf16, WS_BTXO), T, D, D}; pg8::StaticOrder S; S.init(T, D, G, cidx);
        blk::EpiRes E{WSP(float, WS_H1F), WSP(float, WS_S1)};
        pg8::gemm_phase<blk::EpiRes, pg8::StaticOrder, true, true>(F.lds + RING_OFF, g, S, E);
    }) SEAM(8);
    RUN(9, { p9_ln_router(F); }) SEAM(9);
    RUN(10, { p10_scatter(F); }) SEAM(10);
    RUN(11, {
        pg8::Gemm g{WSP(bf16, WS_XS), WSP(bf16, WS_BTUP), RMAX, NE * 4096, D}; blk::SchedMoE S; S.init(WSP(int, WS_TAB), 16, G, cidx, (LAS int*)(F.lds + MISC_OFF + 256), F.tid, WSP(int, WS_XS + 32 * MiB));
        blk::EpiSwiGLU E{WSP(unsigned char, WS_ACT), F.in[21]};
        pg8::gemm_phase<blk::EpiSwiGLU, blk::SchedMoE, true, true, false, true, false, true>(F.lds + RING_OFF, g, S, E);
    }) SEAM(11);
    RUN(12, {
        pg8::Gemm g{WSP(bf16, WS_ACT), WSP(bf16, WS_BTDN), RMAX, NE * 2048, FF}; blk::SchedMoE S; S.init(WSP(int, WS_TAB), 8, G, cidx, (LAS int*)(F.lds + MISC_OFF + 256), F.tid);
        blk::EpiBf16B E{WSP(bf16, WS_YR), D, F.in[23], 7, 3, 2048, W8_INV};
        pg8::gemm_phase<blk::EpiBf16B, blk::SchedMoE, true, true, false, true>(F.lds + RING_OFF, g, S, E);
    }) SEAM(12);
    RUN(13, { p13_combine(F); })
#undef IN
#undef SEAM
}

extern "C" void kernel_launch(void* const* d_in, const int* in_sizes, int n_in, void* d_out, int out_size, void* d_ws, size_t ws_size, hipStream_t stream) {
    static int grid = 0;
    if (grid == 0) {
        if (n_in != 26 || out_size != T * D || ws_size < WS_END) { fprintf(stderr, "kernel_launch: unexpected shapes: n_in %d out %d ws %zu (need %zu)\n", n_in, out_size, ws_size, (size_t)WS_END); grid = -1; return; }
        int dev = 0, cus = 0, per_cu = 0;
        if (hipGetDevice(&dev) != hipSuccess || hipDeviceGetAttribute(&cus, hipDeviceAttributeMultiprocessorCount, dev) != hipSuccess) { grid = -1; return; }
        if (hipFuncSetAttribute((const void*)mk_fwd, hipFuncAttributeMaxDynamicSharedMemorySize, LDS_BYTES) != hipSuccess) { fprintf(stderr, "kernel_launch: hipFuncSetAttribute failed\n"); grid = -1; return; }
        if (hipOccupancyMaxActiveBlocksPerMultiprocessor(&per_cu, (const void*)mk_fwd, NWAVES * 64, LDS_BYTES) != hipSuccess || per_cu < 1)
            fprintf(stderr, "kernel_launch: occupancy query reports %d workgroups per CU\n", per_cu);
        (void)hipGetLastError();
        grid = cus;
    }
    if (grid < 0) return;
    if (hipMemsetAsync((char*)d_ws + WS_CTL, 0, CTL_ZERO_BYTES, stream) != hipSuccess) return;
    Args a{};
    for (int i = 0; i < 26; ++i) a.in[i] = (const float*)d_in[i];
    a.out = (float*)d_out; a.ws = (unsigned char*)d_ws;
#if MK_ONE_LAUNCH
    a.ph_lo = 0; a.ph_hi = NPHASE;
    hipLaunchKernelGGL(mk_fwd, dim3(grid), dim3(NWAVES * 64), LDS_BYTES, stream, a);
#else
    for (int ph = 0; ph < NPHASE; ++ph) { a.ph_lo = ph; a.ph_hi = ph + 1;
        hipLaunchKernelGGL(mk_fwd, dim3(grid), dim3(NWAVES * 64), LDS_BYTES, stream, a); }
#endif
}
```

```cpp
#include <hip/hip_runtime.h>
#include <cstdio>
#include <cstdint>
namespace pg8 {
#define PG8_LAS __attribute__((address_space(3)))
typedef unsigned short bf16_t;
typedef short bf16x8 __attribute__((ext_vector_type(8)));
typedef float f32x4 __attribute__((ext_vector_type(4)));
typedef unsigned u32x4 __attribute__((ext_vector_type(4)));
constexpr int BM = 256, BK = 64, HALF = 128, HTB = HALF * BK * 2  , STAGE_BYTES = 8 * HTB, NXCD = 8, WGM = 8;

__host__ __device__ __forceinline__ int lds_byte(int r, int c) { const int st = (r >> 4) * 2 + (c >> 5), rr = r & 15, cc = c & 31, ob = rr * 64 + cc * 2; return st * 1024 + (ob ^ (((ob >> 9) & 1) << 5)); }
__host__ __device__ __forceinline__ void stage_rc(int b, int& R, int& C) { const int st = b / 1024, sb = b % 1024, swz = sb ^ (((sb >> 9) & 1) << 5); R = (st >> 1) * 16 + swz / 64; C = (st & 1) * 32 + (swz % 64) / 2; }
__host__ __device__ __forceinline__ int perm32(int rho) { const int n = rho >> 4, i = rho & 15; return 8 * (i >> 2) + 4 * n + (i & 3); }

struct Unit { int pm, pn, rm, rn; };
struct Gemm { const bf16_t* A; const bf16_t* Bt; int M, N, K; };

struct StaticOrder {
    int nM, nN, nwg, G, c;
    __host__ __device__ void init(int M, int N, int G_, int c_) { nM = M / BM; nN = N / BM; nwg = nM * nN; G = G_; c = c_; }
    __host__ __device__ __forceinline__ bool next(int i, Unit& u) const {
        const long L = (long)i * G + c; if (L >= nwg) return false;
        int wgid = (int)L; { const int q = nwg / NXCD, r = nwg % NXCD, xcd = wgid % NXCD, off = wgid / NXCD; wgid = (xcd < r ? xcd * (q + 1) : r * (q + 1) + (xcd - r) * q) + off; }
        const int nig = WGM * nN, gid = wgid / nig, fm = gid * WGM, gsz = (nM - fm) < WGM ? (nM - fm) : WGM;
        u.pm = fm + ((wgid % nig) % gsz); u.pn = (wgid % nig) / gsz; return true;
    }
    __device__ __forceinline__ void a_ready(const Unit&) const {}
    __device__ __forceinline__ void done(const Unit&) const {}
};
typedef int i32x8 __attribute__((ext_vector_type(8)));
__device__ __forceinline__ i32x8 ld8(const PG8_LAS unsigned char* p) { typedef int i32x4 __attribute__((ext_vector_type(4))); const i32x4 a = *(const PG8_LAS i32x4*)p, b = *(const PG8_LAS i32x4*)(p + 1024); return __builtin_shufflevector(a, b, 0, 1, 2, 3, 4, 5, 6, 7); }
__device__ __forceinline__ i32x8 cat8(bf16x8 lo, bf16x8 hi) { typedef int i32x4 __attribute__((ext_vector_type(4))); const i32x4 a = __builtin_bit_cast(i32x4, lo), b = __builtin_bit_cast(i32x4, hi); return (i32x8){a[0], a[1], a[2], a[3], b[0], b[1], b[2], b[3]}; }
template <class Epi, class Sched, bool ALIGN_EPI = false, bool SP2 = false, bool HALFCAP = false, bool FP8 = false, bool MIDHOOK = false, bool GATHER = false>
__device__ __forceinline__ void gemm_phase(PG8_LAS unsigned char* lds, const Gemm g, const Sched& S, const Epi& E) {
    const int tid = threadIdx.x, wid = __builtin_amdgcn_readfirstlane(tid >> 6), lane = tid & 63, wr = wid >> 2, wc = wid & 3, fr = lane & 15, fq = lane >> 4;
    const int K = FP8 ? g.K / 2 : g.K, nt = K / BK;
    unsigned voffA[2], voffB[2];
#pragma unroll
    for (int i = 0; i < 2; ++i) { int R, C; stage_rc(tid * 16 + i * 8192, R, C); const int Rb = Epi::PERM ? ((R & ~31) + perm32(R & 31)) : R;
        voffA[i] = (unsigned)(R * K + C) * 2u; voffB[i] = (unsigned)(Rb * K + C) * 2u; }
    const size_t kstep = (size_t)(BK * 2);
    const size_t hstep = (size_t)HALF * K * 2;
    const size_t tstep = 2 * hstep;
    const unsigned ldsw = (unsigned)wid * 1024u;
    const int aoff = lds_byte(wr * 64 + fr, fq * 8), boff = lds_byte(wc * 32 + fr, fq * 8);
#define PG8_SA(b, h) (((b) * 2 + (h)) * HTB)
#define PG8_SB(b, h) ((4 + (b) * 2 + (h)) * HTB)
#define PG8_STAGE(bufoff, gbase, voff) do { _Pragma("unroll") for (int _i = 0; _i < 2; ++_i) \
        __builtin_amdgcn_global_load_lds((const unsigned*)((const char*)(gbase) + (voff)[_i]), (PG8_LAS unsigned*)(lds + (bufoff) + ldsw + _i * 8192), 16, 0, 0); } while (0)
#define PG8_LDA(dst, b, h) do { if constexpr (FP8) { _Pragma("unroll") for (int m = 0; m < 4; ++m) dst##8[m] = ld8(lds + PG8_SA(b, h) + aoff + m * 2048); } else { _Pragma("unroll") for (int m = 0; m < 4; ++m) _Pragma("unroll") for (int k = 0; k < 2; ++k) dst[m][k] = *(const PG8_LAS bf16x8*)(lds + PG8_SA(b, h) + aoff + m * 2048 + k * 1024); } } while (0)
#define PG8_LDB(dst, b, h) do { if constexpr (FP8) { _Pragma("unroll") for (int n = 0; n < 2; ++n) dst##8[n] = ld8(lds + PG8_SB(b, h) + boff + n * 2048); } else { _Pragma("unroll") for (int n = 0; n < 2; ++n) _Pragma("unroll") for (int k = 0; k < 2; ++k) dst[n][k] = *(const PG8_LAS bf16x8*)(lds + PG8_SB(b, h) + boff + n * 2048 + k * 1024); } } while (0)
#define PG8_MMA(ai, bj, At, Bt) do { __builtin_amdgcn_s_setprio(1); _Pragma("unroll") for (int m = 0; m < 4; ++m) _Pragma("unroll") for (int n = 0; n < 2; ++n) { \
        if constexpr (FP8) { asm volatile("v_mfma_scale_f32_16x16x128_f8f6f4 %0, %1, %2, %0, %3, %3 op_sel_hi:[0,0,0]" : "+v"(acc[ai][bj][m][n]) : "v"(Bt##8[n]), "v"(At##8[m]), "v"(sc_one)); } \
        else { _Pragma("unroll") for (int k = 0; k < 2; ++k) acc[ai][bj][m][n] = __builtin_amdgcn_mfma_f32_16x16x32_bf16(Bt[n][k], At[m][k], acc[ai][bj][m][n], 0, 0, 0); } } __builtin_amdgcn_s_setprio(0); } while (0)
#define PG8_WAIT_V(n) asm volatile("s_waitcnt vmcnt(" #n ")" ::: "memory")
#define PG8_WAIT_L(n) asm volatile("s_waitcnt lgkmcnt(" #n ")" ::: "memory")
#define PG8_BAR __builtin_amdgcn_s_barrier()
#define PG8_SCHED __builtin_amdgcn_sched_barrier(0)
    Unit cur, nxt; int ui = 0;
    if (!S.next(0, cur)) return;
    f32x4 acc[2][2][4][2];
#pragma unroll
    for (int a = 0; a < 2; ++a)
#pragma unroll
        for (int b = 0; b < 2; ++b)
#pragma unroll
            for (int m = 0; m < 4; ++m)
#pragma unroll
                for (int n = 0; n < 2; ++n) acc[a][b][m][n] = (f32x4){0.f, 0.f, 0.f, 0.f};
    bf16x8 At[4][2], B0[2][2], B1[2][2];
    i32x8 At8[4], B08[2], B18[2]; const int sc_one = 0x7f7f7f7f;
    const char* cA = (const char*)g.A + (size_t)cur.pm * tstep; const char* cB = (const char*)g.Bt + (size_t)cur.pn * tstep;
    S.a_ready(cur);
    unsigned cof[2][2] = {{0u, 0u}, {0u, 0u}}, nof[2][2] = {{0u, 0u}, {0u, 0u}}; int gR[2] = {0, 0}; unsigned gC[2] = {0u, 0u};
    if constexpr (GATHER) {
#pragma unroll
        for (int i = 0; i < 2; ++i) { int R, C; stage_rc(tid * 16 + i * 8192, R, C); gR[i] = R; gC[i] = (unsigned)C * 2u; }
#pragma unroll
        for (int h = 0; h < 2; ++h)
#pragma unroll
            for (int i = 0; i < 2; ++i) cof[h][i] = (unsigned)S.row_of(0, h * HALF + gR[i]) * (unsigned)(2 * K) + gC[i];
    }
#define PG8_STAGE_GA(bufoff, h, use_next, kb) do { const unsigned _o0 = (use_next) ? nof[h][0] : cof[h][0], _o1 = (use_next) ? nof[h][1] : cof[h][1]; const char* _gb = (const char*)g.A + (kb); \
        __builtin_amdgcn_global_load_lds((const unsigned*)(_gb + _o0), (PG8_LAS unsigned*)(lds + (bufoff) + ldsw), 16, 0, 0); \
        __builtin_amdgcn_global_load_lds((const unsigned*)(_gb + _o1), (PG8_LAS unsigned*)(lds + (bufoff) + ldsw + 8192), 16, 0, 0); } while (0)
    if constexpr (SP2) {
        PG8_STAGE(PG8_SB(0, 0), cB, voffB); PG8_STAGE(PG8_SB(0, 1), cB + hstep, voffB);
        if constexpr (GATHER) { PG8_STAGE_GA(PG8_SA(0, 0), 0, false, 0); PG8_STAGE_GA(PG8_SA(0, 1), 1, false, 0); } else { PG8_STAGE(PG8_SA(0, 0), cA, voffA); PG8_STAGE(PG8_SA(0, 1), cA + hstep, voffA); }
        if (wr == 1) PG8_BAR;
        PG8_WAIT_V(2); PG8_BAR;
        PG8_STAGE(PG8_SB(1, 0), cB + kstep, voffB); if constexpr (GATHER) PG8_STAGE_GA(PG8_SA(1, 0), 0, false, kstep); else PG8_STAGE(PG8_SA(1, 0), cA + kstep, voffA); PG8_STAGE(PG8_SB(1, 1), cB + hstep + kstep, voffB);
        PG8_WAIT_V(6); PG8_BAR;
    } else {
        PG8_STAGE(PG8_SB(0, 0), cB, voffB); PG8_STAGE(PG8_SA(0, 0), cA, voffA); PG8_STAGE(PG8_SB(0, 1), cB + hstep, voffB); PG8_STAGE(PG8_SA(0, 1), cA + hstep, voffA);
        if (wr == 1) PG8_BAR;
        PG8_WAIT_V(4); PG8_BAR;
        PG8_STAGE(PG8_SB(1, 0), cB + kstep, voffB); PG8_STAGE(PG8_SA(1, 0), cA + kstep, voffA); PG8_STAGE(PG8_SB(1, 1), cB + hstep + kstep, voffB);
        PG8_WAIT_V(6); PG8_BAR;
    }
    for (;;) {
        const bool has_next = S.next(ui + 1, nxt);
        const char* nA = has_next ? (const char*)g.A + (size_t)nxt.pm * tstep : cA; const char* nB = has_next ? (const char*)g.Bt + (size_t)nxt.pn * tstep : cB;
        const bool half = HALFCAP && cur.rm != 0;
        if constexpr (GATHER) {
#pragma unroll
            for (int h = 0; h < 2; ++h)
#pragma unroll
                for (int i = 0; i < 2; ++i) nof[h][i] = has_next ? (unsigned)S.row_of(ui + 1, h * HALF + gR[i]) * (unsigned)(2 * K) + gC[i] : cof[h][i];
        }
        for (int t = 0; t < nt; t += 2) {
            const bool last = (t == nt - 2);
            const char* a1 = cA + (size_t)(t + 1) * kstep;
            const char* a2 = last ? nA : cA + (size_t)(t + 2) * kstep; const char* b2 = last ? nB : cB + (size_t)(t + 2) * kstep;
            const char* a3 = a2 + kstep; const char* b3 = b2 + kstep;
            if constexpr (MIDHOOK) { if (t == nt / 2) E.mid(acc, cur, wr, wc, fr, fq); }
            if (last && has_next) S.a_ready(nxt);
            if constexpr (SP2) {
            PG8_LDB(B0, 0, 0); PG8_LDB(B1, 0, 1); PG8_SCHED; PG8_LDA(At, 0, 0); if constexpr (GATHER) PG8_STAGE_GA(PG8_SA(1, 1), 1, false, (size_t)(t + 1) * kstep); else PG8_STAGE(PG8_SA(1, 1), a1 + hstep, voffA);
            PG8_WAIT_V(8); PG8_WAIT_L(0); PG8_BAR; PG8_MMA(0, 0, At, B0); PG8_MMA(0, 1, At, B1); PG8_BAR; PG8_SCHED;
            if (!half) PG8_LDA(At, 0, 1); PG8_STAGE(PG8_SB(0, 0), b2, voffB); PG8_STAGE(PG8_SB(0, 1), b2 + hstep, voffB); if constexpr (GATHER) PG8_STAGE_GA(PG8_SA(0, 0), 0, last, last ? (size_t)0 : (size_t)(t + 2) * kstep); else PG8_STAGE(PG8_SA(0, 0), a2, voffA);
            PG8_WAIT_V(8); PG8_WAIT_L(0); PG8_BAR; if (!half) { PG8_MMA(1, 0, At, B0); PG8_MMA(1, 1, At, B1); } PG8_BAR; PG8_SCHED;
            PG8_LDB(B0, 1, 0); PG8_LDB(B1, 1, 1); PG8_SCHED; PG8_LDA(At, 1, 0); if constexpr (GATHER) PG8_STAGE_GA(PG8_SA(0, 1), 1, last, last ? (size_t)0 : (size_t)(t + 2) * kstep); else PG8_STAGE(PG8_SA(0, 1), a2 + hstep, voffA);
            PG8_WAIT_V(8); PG8_WAIT_L(0); PG8_BAR; PG8_MMA(0, 0, At, B0); PG8_MMA(0, 1, At, B1); PG8_BAR; PG8_SCHED;
            if (!half) PG8_LDA(At, 1, 1); PG8_STAGE(PG8_SB(1, 0), b3, voffB); PG8_STAGE(PG8_SB(1, 1), b3 + hstep, voffB); if constexpr (GATHER) PG8_STAGE_GA(PG8_SA(1, 0), 0, last, last ? kstep : (size_t)(t + 3) * kstep); else PG8_STAGE(PG8_SA(1, 0), a3, voffA);
            PG8_WAIT_V(8); PG8_WAIT_L(0); PG8_BAR; if (!half) { PG8_MMA(1, 0, At, B0); PG8_MMA(1, 1, At, B1); } PG8_BAR; PG8_SCHED;
            } else {
            PG8_LDB(B0, 0, 0); PG8_SCHED; PG8_LDA(At, 0, 0); PG8_STAGE(PG8_SA(1, 1), a1 + hstep, voffA);
            PG8_WAIT_L(8); PG8_BAR; PG8_WAIT_L(0); PG8_MMA(0, 0, At, B0); PG8_BAR; PG8_SCHED;
            PG8_LDB(B1, 0, 1); PG8_STAGE(PG8_SB(0, 0), b2, voffB);
            PG8_BAR; PG8_WAIT_L(0); PG8_MMA(0, 1, At, B1); PG8_BAR;
            PG8_LDA(At, 0, 1); PG8_STAGE(PG8_SA(0, 0), a2, voffA);
            PG8_BAR; PG8_WAIT_L(0); PG8_MMA(1, 0, At, B0); PG8_BAR; PG8_SCHED;
            PG8_STAGE(PG8_SB(0, 1), b2 + hstep, voffB);
            PG8_WAIT_V(6); PG8_BAR; PG8_MMA(1, 1, At, B1); PG8_BAR;
            PG8_LDB(B0, 1, 0); PG8_SCHED; PG8_LDA(At, 1, 0); PG8_STAGE(PG8_SA(0, 1), a2 + hstep, voffA);
            PG8_WAIT_L(8); PG8_BAR; PG8_WAIT_L(0); PG8_MMA(0, 0, At, B0); PG8_BAR; PG8_SCHED;
            PG8_LDB(B1, 1, 1); PG8_STAGE(PG8_SB(1, 0), b3, voffB);
            PG8_BAR; PG8_WAIT_L(0); PG8_MMA(0, 1, At, B1); PG8_BAR;
            PG8_LDA(At, 1, 1); PG8_STAGE(PG8_SA(1, 0), a3, voffA);
            PG8_BAR; PG8_WAIT_L(0); PG8_MMA(1, 0, At, B0); PG8_BAR; PG8_SCHED;
            PG8_STAGE(PG8_SB(1, 1), b3 + hstep, voffB);
            PG8_WAIT_V(6); PG8_BAR; PG8_MMA(1, 1, At, B1); PG8_BAR;
            }
        }
        if constexpr (FP8) asm volatile("s_nop 15\n\ts_nop 15" ::: "memory");
        if constexpr (ALIGN_EPI) { if (wr == 0) PG8_BAR; }
        if constexpr (!Epi::AFTER_DRAIN) { E(acc, cur, wr, wc, fr, fq); S.done(cur); }
        if (!has_next) break;
#pragma unroll
        for (int a = 0; a < 2; ++a)
#pragma unroll
            for (int b = 0; b < 2; ++b)
#pragma unroll
                for (int m = 0; m < 4; ++m)
#pragma unroll
                    for (int n = 0; n < 2; ++n) acc[a][b][m][n] = (f32x4){0.f, 0.f, 0.f, 0.f};
        cur = nxt; cA = nA; cB = nB; ++ui;
        if constexpr (GATHER) { cof[0][0] = nof[0][0]; cof[0][1] = nof[0][1]; cof[1][0] = nof[1][0]; cof[1][1] = nof[1][1]; }
        if constexpr (ALIGN_EPI) { if (wr == 1) PG8_BAR; }
    }
    PG8_WAIT_V(0);
    if constexpr (!ALIGN_EPI) { if (wr == 0) PG8_BAR; }
    PG8_BAR;
    if constexpr (Epi::AFTER_DRAIN) { E.fused(acc, cur, wr, wc, fr, fq, lds, wid, lane); S.done(cur); }
#undef PG8_SA
#undef PG8_SB
#undef PG8_STAGE
#undef PG8_STAGE_GA
#undef PG8_LDA
#undef PG8_LDB
#undef PG8_MMA
#undef PG8_WAIT_V
#undef PG8_WAIT_L
#undef PG8_BAR
#undef PG8_SCHED
}
}

constexpr int NB = 2, SEQ = 4096, T = NB * SEQ, D = 2048, NIN = 8448;
constexpr int C_QA = 0, C_KA = 1024, C_VA = 1152, C_QB = 1280, C_KB = 2304, C_VB = 3328, C_GA = 4352, C_GB = 6400;
constexpr int NE = 32, FF = 2048, MEMLEN = 256;
constexpr int RMAX = 32768 + NE * 256;
constexpr float ALPHA = 1.18920711500272f;
constexpr float LN_EPS = 1e-5f;
constexpr int NWAVES = 8;
#ifndef MK_ONE_LAUNCH
#define MK_ONE_LAUNCH 1
#endif
constexpr int NPHASE = 14;

constexpr size_t MiB = 1u << 20;
constexpr size_t WS_CTL = 0, CTL_ZERO_BYTES = 65536;
constexpr size_t WS_TAB = 1 * MiB;
constexpr size_t WS_ROUTE = 2 * MiB;
constexpr size_t WS_BT1 = 4 * MiB;
constexpr size_t WS_BTAB = 54 * MiB;
constexpr size_t WS_BTMIX = 62 * MiB, WS_BTXQ = 70 * MiB, WS_BTXO = 78 * MiB;
constexpr size_t WS_BTUP = 88 * MiB;
constexpr size_t WS_BTDN = 600 * MiB;
constexpr size_t WS_H0F = 856 * MiB;
constexpr size_t WS_H0B = 920 * MiB;
constexpr size_t WS_PROJ = 954 * MiB;
constexpr size_t WS_KMEM = 1086 * MiB;
constexpr size_t WS_VT = 1088 * MiB;
constexpr size_t WS_OAB = 1090 * MiB;
constexpr size_t WS_G1 = 1122 * MiB;
constexpr size_t WS_GG = 1186 * MiB;
constexpr size_t WS_S1 = 1218 * MiB;
constexpr size_t WS_H1F = 1282 * MiB, WS_H1B = 1346 * MiB, WS_QX = 1378 * MiB, WS_OX = 1410 * MiB, WS_H2F = 1442 * MiB, WS_H2B = 1506 * MiB;
constexpr size_t WS_XS = 1538 * MiB, WS_ACT = 1698 * MiB, WS_YR = 1858 * MiB, WS_END = 2018 * MiB;
static_assert(WS_BT1 + (size_t)12544 * 2048 * 2 <= WS_BTAB && WS_H0B + (size_t)8704 * 2048 * 2 <= WS_PROJ && WS_PROJ + (size_t)T * NIN * 2 <= WS_KMEM && WS_XS + (size_t)RMAX * 2048 * 2 <= WS_ACT, "ws map");

constexpr int CW_TMO = 0, CW_CODE = 1;
constexpr int CW_CNT = 1024;
constexpr int CW_SUB = 3584;
constexpr int CW_BAR = 4096;

constexpr int RING_OFF = 0, RING_BYTES = 131072;
constexpr int LDSCTL_OFF = RING_BYTES, MISC_OFF = LDSCTL_OFF + 320;
constexpr int LDS_BYTES = 147456;

#define GAS __attribute__((address_space(1)))
#define LAS __attribute__((address_space(3)))
typedef unsigned short bf16;
typedef unsigned v4u __attribute__((ext_vector_type(4)));
typedef unsigned v2u __attribute__((ext_vector_type(2)));
typedef float f32x4 __attribute__((ext_vector_type(4)));
typedef GAS unsigned gu32;
#define RLX_AGENT __ATOMIC_RELAXED, __HIP_MEMORY_SCOPE_AGENT
#define LDS_WAIT() asm volatile("s_waitcnt lgkmcnt(0)" ::: "memory")
#define VM_WAIT() asm volatile("s_waitcnt vmcnt(0)" ::: "memory")
typedef float f32x2_ __attribute__((ext_vector_type(2)));
typedef __bf16 bf16x2_ __attribute__((ext_vector_type(2)));
__device__ __forceinline__ unsigned pk2(float lo, float hi) { const f32x2_ v = {lo, hi}; const bf16x2_ b = __builtin_convertvector(v, bf16x2_); return __builtin_bit_cast(unsigned, b); }
__device__ __forceinline__ float bflo(unsigned w) { return __uint_as_float(w << 16); }
__device__ __forceinline__ float bfhi(unsigned w) { return __uint_as_float(w & 0xffff0000u); }
__device__ __forceinline__ float sigmoidf_(float x) { return __builtin_amdgcn_rcpf(1.0f + __expf(-x)); }
__device__ __forceinline__ float wave_sum(float v) {
#pragma unroll
    for (int o = 1; o < 64; o <<= 1) v += __shfl_xor(v, o);
    return v;
}
__device__ __forceinline__ unsigned pk4_fp8(float a, float b, float c, float d) { int w = __builtin_amdgcn_cvt_pk_fp8_f32(a, b, 0, false); w = __builtin_amdgcn_cvt_pk_fp8_f32(c, d, w, true); return (unsigned)w; }
constexpr float W8_SCALE = 64.0f, W8_INV = 1.0f / 64.0f;
#define XB_TMO      128
#define XB_XCNT(j)  (256  + 64 * (j))
#define XB_XSUB(j)  (1280 + 64 * (j))
#define XB_XGEN(j)  (2304 + 64 * (j))
#define XB_TOP      3328
#define XB_TOPGEN   3392
#define XCD_BAR_WORDS 3456
#define XB_SPIN_CAP (1u << 18)

__device__ __forceinline__ unsigned xb_ld(unsigned* p)              { return __hip_atomic_load(p, __ATOMIC_RELAXED, __HIP_MEMORY_SCOPE_AGENT); }
__device__ __forceinline__ unsigned xb_add(unsigned* p, unsigned v) { return __hip_atomic_fetch_add(p, v, __ATOMIC_RELAXED, __HIP_MEMORY_SCOPE_AGENT); }
__device__ __forceinline__ unsigned xb_xcc_id() { return (unsigned)__builtin_amdgcn_s_getreg((3 << 11) | 20) & 0xFu; }
#define XB_SPIN(cond, bar) do { unsigned _sp = 0; while (cond) { __builtin_amdgcn_s_sleep(1); \
    if ((++_sp & 255u) == 0u) { if (xb_ld(&(bar)[XB_TMO])) break; if (_sp > XB_SPIN_CAP) { atomicAdd(&(bar)[XB_TMO], 1u); break; } } } } while (0)

struct XcdBarrier {
    unsigned* bar; unsigned x;
    volatile LAS unsigned* st;
};

__device__ __forceinline__ XcdBarrier xcd_barrier_post(unsigned* bar, volatile LAS unsigned* st) {
    XcdBarrier b; b.bar = bar; b.x = xb_xcc_id(); b.st = st;
    if (threadIdx.x == 0) (void)xb_add(&bar[XB_XCNT(b.x)], 1u);
    return b;
}
__device__ __forceinline__ void xcd_barrier_complete(unsigned* bar, unsigned x, unsigned& nloc, unsigned& nx) {
    const unsigned G = gridDim.x * gridDim.y * gridDim.z;
    unsigned sum, cnt, mine, sp = 0u;
    for (;;) {
        sum = 0u; cnt = 0u; mine = 0u;
#pragma unroll
        for (unsigned j = 0; j < 16; ++j) { const unsigned c = xb_ld(&bar[XB_XCNT(j)]); sum += c; cnt += (c > 0u) ? 1u : 0u; mine = (j == x) ? c : mine; }
        if (sum == G) break;
        __builtin_amdgcn_s_sleep(1);
        if ((++sp & 255u) == 0u) { if (xb_ld(&bar[XB_TMO])) break; if (sp > XB_SPIN_CAP) { atomicAdd(&bar[XB_TMO], 1u); break; } }
    }
    nloc = mine > 0u ? mine : 1u; nx = cnt > 0u ? cnt : 1u;
}

__device__ __forceinline__ void xcd_barrier(const XcdBarrier& b) {
    asm volatile("s_waitcnt vmcnt(0)" ::: "memory");
    __syncthreads();
    if (threadIdx.x == 0) {
        unsigned* bar = b.bar;
        __builtin_amdgcn_s_waitcnt(0);
        unsigned nloc = b.st[0], nx = b.st[1];
        if (nloc == 0u) { xcd_barrier_complete(bar, b.x, nloc, nx); b.st[0] = nloc; b.st[1] = nx; }
        const unsigned old = xb_add(&bar[XB_XSUB(b.x)], 1u);
        const unsigned gen = old / nloc;
        if (old + 1u == (gen + 1u) * nloc) {
            __builtin_amdgcn_fence(__ATOMIC_RELEASE, "agent");
            asm volatile("s_waitcnt vmcnt(0)" ::: "memory");
            const unsigned og = xb_add(&bar[XB_TOP], 1u);
            const unsigned tg = og / nx;
            if (og + 1u == (tg + 1u) * nx) xb_add(&bar[XB_TOPGEN], 1u);
            else XB_SPIN(xb_ld(&bar[XB_TOPGEN]) == tg, bar);
            __builtin_amdgcn_fence(__ATOMIC_ACQUIRE, "agent");
            xb_add(&bar[XB_XGEN(b.x)], 1u);
            asm volatile("s_waitcnt vmcnt(0)" ::: "memory");
        } else {
            XB_SPIN(xb_ld(&bar[XB_XGEN(b.x)]) == gen, bar);
            __builtin_amdgcn_fence(__ATOMIC_ACQUIRE, "agent");
            asm volatile("s_waitcnt vmcnt(0)" ::: "memory");
        }
    }
    __syncthreads();
}

namespace blk {
using pg8::Unit; using pg8::f32x4; using pg8::u32x4; using pg8::bf16_t;
typedef float f32x4_t __attribute__((ext_vector_type(4)));

struct SchedP1 {
    pg8::StaticOrder so;
    __device__ __forceinline__ void init(int G, int c) { so.init(T, NIN, G, c); }
    __device__ __forceinline__ bool next(int i, Unit& u) const {
        const long L = (long)i * so.G + so.c;
        constexpr int MA = (int)(WS_H0B / MiB), MB = (int)(WS_BT1 / MiB);
        if (L < so.nwg) { if (!so.next(i, u)) return false; u.rm = u.pm; u.rn = u.pn; u.pm += MA; u.pn += MB; return true; }
        const int j = (int)(L - so.nwg); if (j >= 32) return false;
        if (j < 16) { const int mb = j & 1, ct = j >> 1; u.pm = MA + 32 + mb; u.pn = MB + 33 + ct; u.rm = mb; u.rn = 64 + ct; }
        else { const int jj = j - 16, dt = jj >> 1, mb = jj & 1; u.pm = MB + 33 + 8 + dt; u.pn = MA + 32 + mb; u.rm = dt; u.rn = 128 + mb; }
        return true;
    }
    __device__ __forceinline__ void a_ready(const Unit&) const {}
    __device__ __forceinline__ void done(const Unit&) const {}
};
struct EpiProj {
    static constexpr bool PERM = true, AFTER_DRAIN = false;
    unsigned char* ws; const float* bias;
    __device__ __forceinline__ void operator()(const f32x4 (&acc)[2][2][4][2], const Unit& u, int wr, int wc, int fr, int fq) const {
        const int kind = u.rn >> 6; const bool mn = kind == 0;
        bf16_t* base = (bf16_t*)(ws + WS_PROJ + (size_t)(kind >= 1) * (WS_KMEM - WS_PROJ) + (size_t)(kind >= 2) * (WS_VT - WS_KMEM)); const int ldc = 512 + (kind <= 1) * 1536 + (kind == 0) * (NIN - 2048);
        const int row0 = u.rm * 256 + wr * 64 + fr, col0 = (u.rn & 63) * 256 + wc * 32 + 8 * fq;
        f32x4 bv[2][2];
#pragma unroll
        for (int bj = 0; bj < 2; ++bj)
#pragma unroll
            for (int n = 0; n < 2; ++n) bv[bj][n] = mn ? *(const f32x4*)(bias + col0 + bj * 128 + 4 * n) : (f32x4){0.f, 0.f, 0.f, 0.f};
#pragma unroll
        for (int ai = 0; ai < 2; ++ai)
#pragma unroll
            for (int m = 0; m < 4; ++m) { bf16_t* rowp = base + (size_t)(row0 + ai * 128 + m * 16) * ldc + col0;
#pragma unroll
                for (int bj = 0; bj < 2; ++bj) { const f32x4 v0 = acc[ai][bj][m][0] + bv[bj][0], v1 = acc[ai][bj][m][1] + bv[bj][1];
                    u32x4 w; w.x = pk2(v0[0], v0[1]); w.y = pk2(v0[2], v0[3]); w.z = pk2(v1[0], v1[1]); w.w = pk2(v1[2], v1[3]);
                    *(u32x4*)(rowp + bj * 128) = w; } }
    }
};
struct EpiBf16B {
    static constexpr bool PERM = true, AFTER_DRAIN = false;
    bf16_t* O; int ldc; const float* bias; int cmask, cshift, bstride; float scale;
    __device__ __forceinline__ void operator()(const f32x4 (&acc)[2][2][4][2], const Unit& u, int wr, int wc, int fr, int fq) const {
        const int row0 = u.pm * 256 + wr * 64 + fr, col0 = (u.pn & cmask) * 256 + wc * 32 + 8 * fq;
        const float* bp = bias ? bias + (size_t)(u.pn >> cshift) * bstride + col0 : nullptr;
        f32x4 bv[2][2];
#pragma unroll
        for (int bj = 0; bj < 2; ++bj)
#pragma unroll
            for (int n = 0; n < 2; ++n) bv[bj][n] = bp ? *(const f32x4*)(bp + bj * 128 + 4 * n) : (f32x4){0.f, 0.f, 0.f, 0.f};
#pragma unroll
        for (int ai = 0; ai < 2; ++ai)
#pragma unroll
            for (int m = 0; m < 4; ++m) { bf16_t* rowp = O + (size_t)(row0 + ai * 128 + m * 16) * ldc + col0;
#pragma unroll
                for (int bj = 0; bj < 2; ++bj) { const f32x4 v0 = acc[ai][bj][m][0] * scale + bv[bj][0], v1 = acc[ai][bj][m][1] * scale + bv[bj][1];
                    u32x4 w; w.x = pk2(v0[0], v0[1]); w.y = pk2(v0[2], v0[3]); w.z = pk2(v1[0], v1[1]); w.w = pk2(v1[2], v1[3]);
                    *(u32x4*)(rowp + bj * 128) = w; } }
    }
};
struct EpiGate {
    static constexpr bool PERM = true, AFTER_DRAIN = false;
    const bf16_t* proj; bf16_t* gg;
    __device__ __forceinline__ static float em(float x) { return __expf(-x); }
    __device__ __forceinline__ void mid(f32x4 (&acc)[2][2][4][2], const Unit& u, int wr, int wc, int fr, int fq) const {
        int row0 = u.pm * 256 + wr * 64 + fr; const int col0 = u.pn * 256 + wc * 32 + 8 * fq;
        asm volatile("" : "+v"(row0));
#pragma unroll
        for (int ai = 0; ai < 2; ++ai)
#pragma unroll
            for (int m = 0; m < 4; ++m) { const size_t row = (size_t)(row0 + ai * 128 + m * 16);
#pragma unroll
                for (int bj = 0; bj < 2; ++bj) {
                    const u32x4 ga = *(const u32x4*)(proj + row * NIN + C_GA + col0 + bj * 128), gb = *(const u32x4*)(proj + row * NIN + C_GB + col0 + bj * 128);
                    const unsigned gaw[4] = {ga.x, ga.y, ga.z, ga.w}, gbw[4] = {gb.x, gb.y, gb.z, gb.w};
#pragma unroll
                    for (int q = 0; q < 4; ++q) {
                        const float r0 = (1.0f + em(fmaxf(bflo(gbw[q]), -60.0f))) * __builtin_amdgcn_rcpf(1.0f + em(bflo(gaw[q]))), r1 = (1.0f + em(fmaxf(bfhi(gbw[q]), -60.0f))) * __builtin_amdgcn_rcpf(1.0f + em(bfhi(gaw[q])));
                        acc[ai][bj][m][q >> 1][2 * (q & 1)] *= r0; acc[ai][bj][m][q >> 1][2 * (q & 1) + 1] *= r1; } }
                asm volatile("" ::: "memory"); }
    }
    __device__ __forceinline__ void operator()(const f32x4 (&acc)[2][2][4][2], const Unit& u, int wr, int wc, int fr, int fq) const {
        int row0 = u.pm * 256 + wr * 64 + fr; const int col0 = u.pn * 256 + wc * 32 + 8 * fq;
        asm volatile("" : "+v"(row0));
#pragma unroll
        for (int ai = 0; ai < 2; ++ai)
#pragma unroll
            for (int m = 0; m < 4; ++m) { const size_t row = (size_t)(row0 + ai * 128 + m * 16);
#pragma unroll
                for (int bj = 0; bj < 2; ++bj) {
                    const u32x4 gb = *(const u32x4*)(proj + row * NIN + C_GB + col0 + bj * 128);
                    const unsigned gbw[4] = {gb.x, gb.y, gb.z, gb.w}; float o[8];
#pragma unroll
                    for (int q = 0; q < 4; ++q) { o[2 * q] = acc[ai][bj][m][q >> 1][2 * (q & 1)] * __builtin_amdgcn_rcpf(1.0f + em(fmaxf(bflo(gbw[q]), -60.0f))); o[2 * q + 1] = acc[ai][bj][m][q >> 1][2 * (q & 1) + 1] * __builtin_amdgcn_rcpf(1.0f + em(fmaxf(bfhi(gbw[q]), -60.0f))); }
                    u32x4 w; w.x = pk2(o[0], o[1]); w.y = pk2(o[2], o[3]); w.z = pk2(o[4], o[5]); w.w = pk2(o[6], o[7]);
                    *(u32x4*)(gg + row * D + col0 + bj * 128) = w; } }
    }
};
struct EpiRes {
    static constexpr bool PERM = false, AFTER_DRAIN = false;
    const bf16_t* res; float* out;
    __device__ __forceinline__ void operator()(const f32x4 (&acc)[2][2][4][2], const Unit& u, int wr, int wc, int fr, int fq) const {
        const int row0 = u.pm * 256 + wr * 64 + fr, col0 = u.pn * 256 + wc * 32 + 4 * fq;
#pragma unroll
        for (int ai = 0; ai < 2; ++ai)
#pragma unroll
            for (int m = 0; m < 4; ++m) { const size_t off = (size_t)(row0 + ai * 128 + m * 16) * D + col0;
#pragma unroll
                for (int bj = 0; bj < 2; ++bj)
#pragma unroll
                    for (int n = 0; n < 2; ++n) { const v2u rw = *(const v2u*)(res + off + bj * 128 + n * 16); const f32x4 r = {bflo(rw.x), bfhi(rw.x), bflo(rw.y), bfhi(rw.y)};
                        *(f32x4*)(out + off + bj * 128 + n * 16) = r * ALPHA + acc[ai][bj][m][n]; } }
    }
};
struct SchedMoE {
    static constexpr int RT_LDS = 12;
    const PG8_LAS int* mine; const PG8_LAS int* rts; const int* rowtok; int n;
    __device__ __forceinline__ void init(const int* tab, int nN, int G, int c, PG8_LAS int* lds_list, int tid, const int* rowtok_ = nullptr) {
        const int nwg = tab[192] * nN; const int* ul = tab + (nN == 16 ? 1024 : 8192);
        n = c < nwg ? (nwg - c + G - 1) / G : 0;
        if (tid < n && tid < 256) lds_list[tid] = ul[tid * G + c];
        rowtok = rowtok_; PG8_LAS int* r = lds_list + 256;
        if (rowtok_) { for (int i = 0; i < n && i < RT_LDS; ++i) { const int pm = ul[i * G + c] & 0xffff; if (tid < 256) r[i * 256 + tid] = rowtok_[pm * 256 + tid]; } }
        __syncthreads();
        mine = lds_list; rts = r;
    }
    __device__ __forceinline__ bool next(int i, Unit& u) const {
        if (i >= n) return false;
        const int x = mine[i]; u.pm = x & 0xffff; u.pn = x >> 16; u.rm = 0; u.rn = 0; return true;
    }
    __device__ __forceinline__ int row_of(int i, int r) const { return i < RT_LDS ? rts[i * 256 + r] : rowtok[(mine[i] & 0xffff) * 256 + r]; }
    __device__ __forceinline__ void a_ready(const Unit&) const {}
    __device__ __forceinline__ void done(const Unit&) const {}
};
struct EpiSwiGLU {
    static constexpr bool PERM = true, AFTER_DRAIN = false;
    unsigned char* act; const float* b_up;
    __device__ __forceinline__ void operator()(const f32x4 (&acc)[2][2][4][2], const Unit& u, int wr, int wc, int fr, int fq) const {
        const int e = u.pn >> 4, ct = u.pn & 15;
        const int row0 = u.pm * 256 + wr * 64 + fr, c8 = ct * 128 + wc * 32 + 8 * fq;
        f32x4 bg[2], bl[2];
#pragma unroll
        for (int n = 0; n < 2; ++n) { bg[n] = *(const f32x4*)(b_up + (size_t)e * 4096 + c8 + 4 * n); bl[n] = *(const f32x4*)(b_up + (size_t)e * 4096 + 2048 + c8 + 4 * n); }
#pragma unroll
        for (int ai = 0; ai < 2; ++ai)
#pragma unroll
            for (int m = 0; m < 4; ++m) { unsigned char* rowp = act + (size_t)(row0 + ai * 128 + m * 16) * FF + c8;
                float a[8];
#pragma unroll
                for (int n = 0; n < 2; ++n) { const f32x4 g = acc[ai][0][m][n] * W8_INV + bg[n], l = acc[ai][1][m][n] * W8_INV + bl[n];
#pragma unroll
                    for (int j = 0; j < 4; ++j) { const float gl = fminf(g[j], 7.0f), li = fminf(fmaxf(l[j], -7.0f), 7.0f);
                        a[4 * n + j] = gl * sigmoidf_(1.702f * gl) * (li + 1.0f); } }
                v2u w; w.x = pk4_fp8(a[0], a[1], a[2], a[3]); w.y = pk4_fp8(a[4], a[5], a[6], a[7]);
                *(v2u*)rowp = w; }
    }
};
}

struct Frame {
    LAS unsigned char* lds;
    volatile LAS unsigned* MISC;
    gu32* ctl;
    int tid, lane, wave, vcu, G;
    const float* const* in; float* out; unsigned char* ws;
};
#define WSP(type, off) ((type*)(F.ws + (off)))

#ifndef CVT_HASH
#define CVT_HASH 0
#endif
struct CvtMat { const float* W; void* WT; int K, N, drow_base, upperm, total, pitch, koff; };
constexpr int CVT_LP16 = 4;
constexpr int CVT_LP8 = 3;
template <bool FP8> __device__ __forceinline__ void cvt_addr(const CvtMat& M, int it_, const float*& src, unsigned char*& dst) {
    int it = it_;
    constexpr int LP = FP8 ? CVT_LP8 : CVT_LP16, KTS = 10 - LP, NTS = 2 + LP;
    if (FP8 && CVT_HASH) it = (int)(((unsigned)it * 40503u) & (unsigned)(M.total - 1));
    const int nblk = M.N >> NTS, per_e = (M.K >> KTS) * nblk, e = it / per_e, r = it - e * per_e, kb = r / nblk, nb = r - kb * nblk, n0 = nb << NTS;
    int drow = M.drow_base + n0;
    if (M.upperm) { const int half = n0 >= 2048 ? 1 : 0, nn = n0 - half * 2048; drow = (nn >> 7) * 256 + half * 128 + (nn & 127); }
    src = M.W + ((size_t)e * M.K + (kb << KTS)) * M.N + n0;
    dst = (unsigned char*)M.WT + (((size_t)e * M.N + drow) * M.pitch + M.koff + (kb << KTS)) * (FP8 ? 1 : 2);
}
__device__ __forceinline__ void tr_load(f32x4 (&v)[16], const float* src, int N, unsigned loff) {
    const unsigned long long base = (unsigned long long)src;
    const unsigned blo = __builtin_amdgcn_readfirstlane((unsigned)base), bhi = __builtin_amdgcn_readfirstlane((unsigned)(base >> 32));
    const unsigned long long ub = ((unsigned long long)bhi << 32) | blo; const unsigned long long rstep = (unsigned long long)(unsigned)N * 4ull;
#pragma unroll
    for (int i = 0; i < 16; ++i) { const unsigned long long rb = ub + (unsigned long long)i * rstep;
        asm volatile("global_load_dwordx4 %0, %1, %2 nt" : "=&v"(v[i]) : "v"(loff), "s"(rb) : "memory"); }
}
template <int NYOUNG> __device__ __forceinline__ void tr_wait(f32x4 (&v)[16]) {
    asm volatile("s_waitcnt vmcnt(%16)" : "+v"(v[0]), "+v"(v[1]), "+v"(v[2]), "+v"(v[3]), "+v"(v[4]), "+v"(v[5]), "+v"(v[6]), "+v"(v[7]), "+v"(v[8]), "+v"(v[9]), "+v"(v[10]), "+v"(v[11]), "+v"(v[12]), "+v"(v[13]), "+v"(v[14]), "+v"(v[15]) : "n"(NYOUNG) : "memory");
}
__device__ __forceinline__ void tr_store(const f32x4 (&v)[16], unsigned char* dst8, int K, int lane) {
    bf16* d0 = (bf16*)dst8 + (size_t)(4 * (lane & ((1 << CVT_LP16) - 1))) * K + 16 * (lane >> CVT_LP16);
#pragma unroll
    for (int j = 0; j < 4; ++j) {
        v4u lo, hi;
        lo.x = pk2(v[0][j], v[1][j]); lo.y = pk2(v[2][j], v[3][j]); lo.z = pk2(v[4][j], v[5][j]); lo.w = pk2(v[6][j], v[7][j]);
        hi.x = pk2(v[8][j], v[9][j]); hi.y = pk2(v[10][j], v[11][j]); hi.z = pk2(v[12][j], v[13][j]); hi.w = pk2(v[14][j], v[15][j]);
        bf16* d = d0 + (size_t)j * K;
        *(v4u*)d = lo; *(v4u*)(d + 8) = hi;
    }
}
__device__ __forceinline__ void tr_store_fp8(const f32x4 (&v)[16], unsigned char* dst8, int K, int lane) {
    unsigned char* d0 = dst8 + (size_t)(4 * (lane & ((1 << CVT_LP8) - 1))) * K + 16 * (lane >> CVT_LP8);
#pragma unroll
    for (int j = 0; j < 4; ++j) {
        v4u o;
        o.x = pk4_fp8(v[0][j] * W8_SCALE, v[1][j] * W8_SCALE, v[2][j] * W8_SCALE, v[3][j] * W8_SCALE); o.y = pk4_fp8(v[4][j] * W8_SCALE, v[5][j] * W8_SCALE, v[6][j] * W8_SCALE, v[7][j] * W8_SCALE);
        o.z = pk4_fp8(v[8][j] * W8_SCALE, v[9][j] * W8_SCALE, v[10][j] * W8_SCALE, v[11][j] * W8_SCALE); o.w = pk4_fp8(v[12][j] * W8_SCALE, v[13][j] * W8_SCALE, v[14][j] * W8_SCALE, v[15][j] * W8_SCALE);
        __builtin_nontemporal_store(o, (v4u*)(d0 + (size_t)j * K));
    }
}
template <bool FP8> __device__ __forceinline__ void convert_mat(const CvtMat& M, int total, int wi, int nw, int lane) {
    constexpr int LP = FP8 ? CVT_LP8 : CVT_LP16;
    const unsigned loff = (unsigned)((16 * (lane >> LP)) * M.N + 4 * (lane & ((1 << LP) - 1))) * 4u;
    int it = wi;
    if constexpr (FP8) {
        for (; it + nw < total; it += 2 * nw) {
            const float* s0; const float* s1; unsigned char* d0; unsigned char* d1;
            cvt_addr<FP8>(M, it, s0, d0); cvt_addr<FP8>(M, it + nw, s1, d1);
            f32x4 v0[16], v1[16];
            tr_load(v0, s0, M.N, loff); tr_load(v1, s1, M.N, loff);
            tr_wait<16>(v0); tr_store_fp8(v0, d0, M.pitch, lane);
            tr_wait<0>(v1); tr_store_fp8(v1, d1, M.pitch, lane);
        }
    }
    if constexpr (!FP8)
    for (; it + 2 * nw < total; it += 3 * nw) {
        const float* s0; const float* s1; const float* s2; unsigned char* d0; unsigned char* d1; unsigned char* d2;
        cvt_addr<FP8>(M, it, s0, d0); cvt_addr<FP8>(M, it + nw, s1, d1); cvt_addr<FP8>(M, it + 2 * nw, s2, d2);
        f32x4 v0[16], v1[16], v2[16];
        tr_load(v0, s0, M.N, loff); tr_load(v1, s1, M.N, loff); tr_load(v2, s2, M.N, loff);
        tr_wait<32>(v0); if (FP8) tr_store_fp8(v0, d0, M.pitch, lane); else tr_store(v0, d0, M.pitch, lane);
        tr_wait<16>(v1); if (FP8) tr_store_fp8(v1, d1, M.pitch, lane); else tr_store(v1, d1, M.pitch, lane);
        tr_wait<0>(v2); if (FP8) tr_store_fp8(v2, d2, M.pitch, lane); else tr_store(v2, d2, M.pitch, lane);
    }
    for (; it < total; it += nw) {
        const float* s0; unsigned char* d0; cvt_addr<FP8>(M, it, s0, d0);
        f32x4 v0[16]; tr_load(v0, s0, M.N, loff); tr_wait<0>(v0); if (FP8) tr_store_fp8(v0, d0, M.pitch, lane); else tr_store(v0, d0, M.pitch, lane);
    }
}
__device__ __forceinline__ void ln_row(f32x4 (&v)[8], const float* g, const float* b, int lane) {
    float s = 0.f;
#pragma unroll
    for (int j = 0; j < 8; ++j) s += (v[j][0] + v[j][1]) + (v[j][2] + v[j][3]);
    const float mean = wave_sum(s) * (1.f / D);
    float s2 = 0.f;
#pragma unroll
    for (int j = 0; j < 8; ++j) { v[j] = v[j] - mean; s2 += (v[j][0] * v[j][0] + v[j][1] * v[j][1]) + (v[j][2] * v[j][2] + v[j][3] * v[j][3]); }
    const float rstd = 1.0f / sqrtf(wave_sum(s2) * (1.f / D) + LN_EPS);
#pragma unroll
    for (int j = 0; j < 8; ++j) { const f32x4 gg = ((const f32x4*)g)[lane + 64 * j], bb = ((const f32x4*)b)[lane + 64 * j]; v[j] = v[j] * rstd * gg + bb; }
}
__device__ __forceinline__ void row_load(f32x4 (&v)[8], const float* p, int lane) {
#pragma unroll
    for (int j = 0; j < 8; ++j) v[j] = ((const f32x4*)p)[lane + 64 * j];
}
__device__ __forceinline__ void row_store_f32(const f32x4 (&v)[8], float* p, int lane) {
#pragma unroll
    for (int j = 0; j < 8; ++j) ((f32x4*)p)[lane + 64 * j] = v[j];
}
__device__ __forceinline__ void row_store_bf16(const f32x4 (&v)[8], bf16* p, int lane) {
#pragma unroll
    for (int j = 0; j < 8; ++j) { v2u w; w.x = pk2(v[j][0], v[j][1]); w.y = pk2(v[j][2], v[j][3]); ((v2u*)p)[lane + 64 * j] = w; }
}

__device__ __forceinline__ void p0_prologue(Frame& F) {
    const int gw = F.vcu * NWAVES + F.wave, NGW = F.G * NWAVES;
    { const CvtMat M{F.in[5], WSP(bf16, WS_BT1), 2048, NIN, 0, 0, 32 * 132, 2048, 0}; convert_mat<false>(M, 32 * 132, gw, NGW, F.lane); }
    { const CvtMat M{F.in[14], WSP(bf16, WS_BT1), 2048, 4096, NIN, 0, 32 * 64, 2048, 0}; convert_mat<false>(M, 32 * 64, gw, NGW, F.lane); }
    for (int m = gw; m < T; m += NGW) {
        f32x4 v[8]; row_load(v, F.in[0] + (size_t)m * D, F.lane);
        ln_row(v, F.in[2], F.in[3], F.lane);
        row_store_bf16(v, WSP(bf16, WS_H0B) + (size_t)m * D, F.lane);
    }
    for (int m = gw; m < NB * MEMLEN; m += NGW) {
        f32x4 v[8]; row_load(v, F.in[1] + (size_t)m * D, F.lane);
        row_store_bf16(v, WSP(bf16, WS_H0B) + (size_t)(T + m) * D, F.lane);
    }
}

__device__ __forceinline__ void cvt_role_p1(Frame& F, int wi, int nw) {
    { const CvtMat M{F.in[8], WSP(bf16, WS_BTAB), 1024, 2048, 0, 0, 16 * 32, 2048, 0}; convert_mat<false>(M, 16 * 32, wi, nw, F.lane); }
    { const CvtMat M{F.in[9], WSP(bf16, WS_BTAB), 1024, 2048, 0, 0, 16 * 32, 2048, 1024}; convert_mat<false>(M, 16 * 32, wi, nw, F.lane); }
    { const CvtMat M{F.in[10], WSP(bf16, WS_BTMIX), 2048, 2048, 0, 0, 32 * 32, 2048, 0}; convert_mat<false>(M, 32 * 32, wi, nw, F.lane); }
    { const CvtMat M{F.in[13], WSP(bf16, WS_BTXQ), 2048, 2048, 0, 0, 32 * 32, 2048, 0}; convert_mat<false>(M, 32 * 32, wi, nw, F.lane); }
    { const CvtMat M{F.in[15], WSP(bf16, WS_BTXO), 2048, 2048, 0, 0, 32 * 32, 2048, 0}; convert_mat<false>(M, 32 * 32, wi, nw, F.lane); }
    { const CvtMat M{F.in[20], WSP(bf16, WS_BTUP), 2048, 4096, 0, 1, NE * 32 * 64, 2048, 0}; convert_mat<true>(M, NE * 32 * 64, wi, nw, F.lane); }
    { const CvtMat M{F.in[22], WSP(bf16, WS_BTDN), 2048, 2048, 0, 0, NE * 32 * 32, 2048, 0}; convert_mat<true>(M, NE * 32 * 32, wi, nw, F.lane); }
}
__device__ __forceinline__ void cvt_role_p11(Frame& F, int wi, int nw) {
    const CvtMat M{F.in[22], WSP(bf16, WS_BTDN), 2048, 2048, 0, 0, NE * 32 * 32, 2048, 0}; convert_mat<true>(M, NE * 32 * 32, wi, nw, F.lane);
}
__device__ __forceinline__ int t5_bucket(int rel) {
    const int n = rel < 0 ? -rel : rel, base = rel > 0 ? 16 : 0;
    const int large = 8 + (n >= 12) + (n >= 16) + (n >= 23) + (n >= 32) + (n >= 46) + (n >= 64) + (n >= 91);
    return base + (n < 8 ? n : large);
}
__device__ __forceinline__ void load_row64(float (&q)[64], const bf16* p, float scale) {
#pragma unroll
    for (int i = 0; i < 8; ++i) { const v4u w = ((const v4u*)p)[i];
        q[8 * i + 0] = bflo(w.x) * scale; q[8 * i + 1] = bfhi(w.x) * scale; q[8 * i + 2] = bflo(w.y) * scale; q[8 * i + 3] = bfhi(w.y) * scale;
        q[8 * i + 4] = bflo(w.z) * scale; q[8 * i + 5] = bfhi(w.z) * scale; q[8 * i + 6] = bflo(w.w) * scale; q[8 * i + 7] = bfhi(w.w) * scale; }
}
__device__ __forceinline__ float dot_row64(const float (&q)[64], const bf16* p) {
    float s0 = 0.f, s1 = 0.f;
#pragma unroll
    for (int i = 0; i < 8; ++i) { const v4u w = ((const v4u*)p)[i];
        s0 += q[8 * i + 0] * bflo(w.x); s1 += q[8 * i + 1] * bfhi(w.x); s0 += q[8 * i + 2] * bflo(w.y); s1 += q[8 * i + 3] * bfhi(w.y);
        s0 += q[8 * i + 4] * bflo(w.z); s1 += q[8 * i + 5] * bfhi(w.z); s0 += q[8 * i + 6] * bflo(w.w); s1 += q[8 * i + 7] * bfhi(w.w); }
    return s0 + s1;
}
__device__ __forceinline__ void axpy_row64(float (&o)[64], float a, float p, const bf16* vp) {
#pragma unroll
    for (int i = 0; i < 8; ++i) { const v4u w = ((const v4u*)vp)[i];
        o[8 * i + 0] = o[8 * i + 0] * a + p * bflo(w.x); o[8 * i + 1] = o[8 * i + 1] * a + p * bfhi(w.x); o[8 * i + 2] = o[8 * i + 2] * a + p * bflo(w.y); o[8 * i + 3] = o[8 * i + 3] * a + p * bfhi(w.y);
        o[8 * i + 4] = o[8 * i + 4] * a + p * bflo(w.z); o[8 * i + 5] = o[8 * i + 5] * a + p * bfhi(w.z); o[8 * i + 6] = o[8 * i + 6] * a + p * bflo(w.w); o[8 * i + 7] = o[8 * i + 7] * a + p * bfhi(w.w); }
}
__device__ __forceinline__ void store_row64(const float (&o)[64], float scale, bf16* p) {
#pragma unroll
    for (int i = 0; i < 8; ++i) { v4u w; w.x = pk2(o[8 * i] * scale, o[8 * i + 1] * scale); w.y = pk2(o[8 * i + 2] * scale, o[8 * i + 3] * scale); w.z = pk2(o[8 * i + 4] * scale, o[8 * i + 5] * scale); w.w = pk2(o[8 * i + 6] * scale, o[8 * i + 7] * scale);
        ((v4u*)p)[i] = w; }
}
typedef short bf16x8 __attribute__((ext_vector_type(8)));
typedef float f32x16 __attribute__((ext_vector_type(16)));
#define MFMA32(a, b, c) __builtin_amdgcn_mfma_f32_32x32x16_bf16((a), (b), (c), 0, 0, 0)
__device__ __forceinline__ void p7_cross_mfma(Frame& F) {
    const bf16* qx = WSP(bf16, WS_QX); const bf16* kmem = WSP(bf16, WS_KMEM); const bf16* vT = WSP(bf16, WS_VT); bf16* ox = WSP(bf16, WS_OX);
    LAS unsigned char* L = F.lds + RING_OFF;
    constexpr int P_OFF = 0, P_STRIDE = 528, KV_OFF = 128 * P_STRIDE, K_STRIDE = 144, V_STRIDE = 528, ST_OFF = KV_OFF + 256 * K_STRIDE;
    static_assert(ST_OFF + 2048 <= RING_BYTES && 64 * V_STRIDE <= 256 * K_STRIDE, "cross-attention LDS map");
    const int w = F.wave, qt = w & 3, kh = w >> 2, r = F.lane & 31, h = F.lane >> 5, tid = F.tid;
    const float c2 = 0.044194173824159216f * 1.4426950408889634f;
    for (int u = F.vcu; u < 256; u += F.G) {
        const int b = u >> 7, head = (u >> 5) & 3, qblk = u & 31; const size_t row0 = (size_t)b * SEQ + qblk * 128;
        const bf16* qrow = qx + (row0 + qt * 32 + r) * D + head * 512 + 8 * h;
        const bf16* kbase = kmem + (size_t)b * MEMLEN * 2048 + head * 512;
        f32x16 sacc[4];
#pragma unroll
        for (int kt = 0; kt < 4; ++kt)
#pragma unroll
            for (int i = 0; i < 16; ++i) sacc[kt][i] = 0.f;
        v4u kst[4]; bf16x8 qf[4], qn[4];
#pragma unroll
        for (int j = 0; j < 4; ++j) { const int p = tid + 512 * j; kst[j] = *(const v4u*)(kbase + (size_t)(p >> 3) * 2048 + (p & 7) * 8); }
#pragma unroll
        for (int s = 0; s < 4; ++s) qf[s] = *(const bf16x8*)(qrow + 16 * s);
        for (int c = 0; c < 8; ++c) {
#pragma unroll
            for (int j = 0; j < 4; ++j) { const int p = tid + 512 * j; *(LAS v4u*)(L + KV_OFF + (p >> 3) * K_STRIDE + (p & 7) * 16) = kst[j]; }
            __syncthreads();
            if (c < 7) {
#pragma unroll
                for (int j = 0; j < 4; ++j) { const int p = tid + 512 * j; kst[j] = *(const v4u*)(kbase + (size_t)(p >> 3) * 2048 + (c + 1) * 64 + (p & 7) * 8); }
#pragma unroll
                for (int s = 0; s < 4; ++s) qn[s] = *(const bf16x8*)(qrow + (c + 1) * 64 + 16 * s);
            }
#pragma unroll
            for (int s = 0; s < 4; ++s)
#pragma unroll
                for (int kt = 0; kt < 4; ++kt) { const bf16x8 kf = *(const LAS bf16x8*)(L + KV_OFF + (kh * 128 + kt * 32 + r) * K_STRIDE + (16 * s + 8 * h) * 2);
                    sacc[kt] = MFMA32(kf, qf[s], sacc[kt]); }
            __syncthreads();
#pragma unroll
            for (int s = 0; s < 4; ++s) qf[s] = qn[s];
        }
        LAS float* mx = (LAS float*)(L + ST_OFF); LAS float* ls = mx + 256;
        float mloc = -3.0e38f;
#pragma unroll
        for (int kt = 0; kt < 4; ++kt)
#pragma unroll
            for (int i = 0; i < 16; ++i) mloc = fmaxf(mloc, sacc[kt][i]);
        mloc = fmaxf(mloc, __shfl_xor(mloc, 32));
        if (h == 0) mx[kh * 128 + qt * 32 + r] = mloc;
        __syncthreads();
        const float m = fmaxf(mx[qt * 32 + r], mx[128 + qt * 32 + r]);
        float lsum = 0.f;
#pragma unroll
        for (int kt = 0; kt < 4; ++kt)
#pragma unroll
            for (int i = 0; i < 16; ++i) { const float p = __builtin_amdgcn_exp2f((sacc[kt][i] - m) * c2); sacc[kt][i] = p; lsum += p; }
        lsum += __shfl_xor(lsum, 32);
        if (h == 0) ls[kh * 128 + qt * 32 + r] = lsum;
        __syncthreads();
        const float inv = 1.0f / (ls[qt * 32 + r] + ls[128 + qt * 32 + r]);
#pragma unroll
        for (int kt = 0; kt < 4; ++kt)
#pragma unroll
            for (int g = 0; g < 4; ++g) { v2u wv; wv.x = pk2(sacc[kt][4 * g] * inv, sacc[kt][4 * g + 1] * inv); wv.y = pk2(sacc[kt][4 * g + 2] * inv, sacc[kt][4 * g + 3] * inv);
                *(LAS v2u*)(L + P_OFF + (qt * 32 + r) * P_STRIDE + (kh * 128 + kt * 32 + 8 * g + 4 * h) * 2) = wv; }
        __syncthreads();
        bf16x8 pf[16];
#pragma unroll
        for (int s = 0; s < 16; ++s) pf[s] = *(const LAS bf16x8*)(L + P_OFF + (qt * 32 + r) * P_STRIDE + (16 * s + 8 * h) * 2);
        const bf16* vbase = vT + (size_t)head * 512 * 512 + b * MEMLEN;
        v4u vst[4];
#pragma unroll
        for (int j = 0; j < 4; ++j) { const int p = tid + 512 * j, row = p >> 5; vst[j] = *(const v4u*)(vbase + (size_t)((row >> 5) * 256 + (row & 31)) * 512 + (p & 31) * 8); }
        for (int i = 0; i < 8; ++i) {
#pragma unroll
            for (int j = 0; j < 4; ++j) { const int p = tid + 512 * j; *(LAS v4u*)(L + KV_OFF + (p >> 5) * V_STRIDE + (p & 31) * 16) = vst[j]; }
            __syncthreads();
            if (i < 7) {
#pragma unroll
                for (int j = 0; j < 4; ++j) { const int p = tid + 512 * j, row = p >> 5; vst[j] = *(const v4u*)(vbase + (size_t)((row >> 5) * 256 + (i + 1) * 32 + (row & 31)) * 512 + (p & 31) * 8); }
            }
            f32x16 acc;
#pragma unroll
            for (int k = 0; k < 16; ++k) acc[k] = 0.f;
#pragma unroll
            for (int s = 0; s < 16; ++s) { const bf16x8 vf = *(const LAS bf16x8*)(L + KV_OFF + (kh * 32 + r) * V_STRIDE + (16 * s + 8 * h) * 2); acc = MFMA32(vf, pf[s], acc); }
            bf16* op = ox + (row0 + qt * 32 + r) * D + head * 512 + (kh * 8 + i) * 32 + 4 * h;
#pragma unroll
            for (int g = 0; g < 4; ++g) { v2u wv; wv.x = pk2(acc[4 * g], acc[4 * g + 1]); wv.y = pk2(acc[4 * g + 2], acc[4 * g + 3]); *(v2u*)(op + 8 * g) = wv; }
            __syncthreads();
        }
    }
}
__device__ __forceinline__ int crow16(int i, int hh) { return (i & 3) + 8 * (i >> 2) + 4 * hh; }
__device__ __forceinline__ bf16x8 pack8(const f32x16& x, int s) {
    v4u p; p.x = pk2(x[8 * s], x[8 * s + 1]); p.y = pk2(x[8 * s + 2], x[8 * s + 3]); p.z = pk2(x[8 * s + 4], x[8 * s + 5]); p.w = pk2(x[8 * s + 6], x[8 * s + 7]);
    return __builtin_bit_cast(bf16x8, p);
}
__device__ __forceinline__ bf16x8 vt_frag(const LAS unsigned char* p) {
    const v2u lo = *(const LAS v2u*)p, hi = *(const LAS v2u*)(p + 16); v4u w; w.x = lo.x; w.y = lo.y; w.z = hi.x; w.w = hi.y; return __builtin_bit_cast(bf16x8, w);
}
__device__ __forceinline__ void vt_scatter(LAS unsigned char* vt, int stride, int c16, int key, v4u w) {
    LAS unsigned short* p = (LAS unsigned short*)(vt + (c16 * 8) * stride + key * 2); const int st = stride / 2;
    p[0] = (unsigned short)w.x; p[st] = (unsigned short)(w.x >> 16); p[2 * st] = (unsigned short)w.y; p[3 * st] = (unsigned short)(w.y >> 16);
    p[4 * st] = (unsigned short)w.z; p[5 * st] = (unsigned short)(w.z >> 16); p[6 * st] = (unsigned short)w.w; p[7 * st] = (unsigned short)(w.w >> 16);
}
__device__ __forceinline__ void p2_swa_mfma(Frame& F, int uc, int uG) {
    const bf16* proj = WSP(bf16, WS_PROJ); bf16* oa = WSP(bf16, WS_OAB);
    const float* relb = F.in[4]; const float* sinks = F.in[7];
    LAS unsigned char* L = F.lds + RING_OFF;
    constexpr int K_OFF = 0, K_STRIDE = 144, VT_OFF = 192 * K_STRIDE, VT_STRIDE = 392, BT_OFF = VT_OFF + 64 * VT_STRIDE;
    static_assert(BT_OFF + 8 * 256 * 4 <= RING_BYTES && BT_OFF % 16 == 0, "swa LDS map");
    const int w = F.wave, r = F.lane & 31, hh = F.lane >> 5, tid = F.tid;
    for (int u = uc; u < 256; u += uG) {
        const int b = u >> 7, g = (u >> 6) & 1, c = u & 63, h = g * 8 + w;
        const int k_lo = (c >= 2 ? c - 2 : 0) * 64, nk = c * 64 + 64 - k_lo, nkt = nk >> 5;
        const bf16* kvbase = proj + ((size_t)b * SEQ + k_lo) * NIN + g * 64;
#pragma unroll
        for (int j = 0; j < 3; ++j) { const int p = tid + 512 * j;
            if (p < nk * 8) { const int key = p >> 3, c16 = p & 7; const bf16* src = kvbase + (size_t)key * NIN + c16 * 8;
                *(LAS v4u*)(L + K_OFF + key * K_STRIDE + c16 * 16) = *(const v4u*)(src + C_KA);
                vt_scatter(L + VT_OFF, VT_STRIDE, c16, key, *(const v4u*)(src + C_VA)); } }
        LAS float* tab = (LAS float*)(L + BT_OFF) + w * 256;
#pragma unroll
        for (int j = 0; j < 4; ++j) { const int idx = F.lane + 64 * j; if (idx < 255) tab[idx] = relb[t5_bucket(idx - 191) * 16 + h]; }
        __syncthreads();
        const float sink = sinks[h];
        const int ibase = k_lo - c * 64 + 191;
#pragma unroll 1
        for (int qt = 0; qt < 2; ++qt) {
            const size_t row = (size_t)b * SEQ + c * 64 + qt * 32 + r;
            bf16x8 qf[4];
#pragma unroll
            for (int s = 0; s < 4; ++s) qf[s] = *(const bf16x8*)(proj + row * NIN + C_QA + h * 64 + 16 * s + 8 * hh);
            f32x16 sacc[6];
#pragma unroll
            for (int kt = 0; kt < 6; ++kt)
#pragma unroll
                for (int i = 0; i < 16; ++i) sacc[kt][i] = 0.f;
#pragma unroll
            for (int kt = 0; kt < 6; ++kt) if (kt < nkt) {
#pragma unroll
                for (int s = 0; s < 4; ++s) { const bf16x8 kf = *(const LAS bf16x8*)(L + K_OFF + (kt * 32 + r) * K_STRIDE + (16 * s + 8 * hh) * 2); sacc[kt] = MFMA32(kf, qf[s], sacc[kt]); } }
            float m = sink;
#pragma unroll
            for (int kt = 0; kt < 6; ++kt) if (kt < nkt) {
#pragma unroll
                for (int i = 0; i < 16; ++i) { const float sv = sacc[kt][i] * 0.125f + tab[ibase + kt * 32 + crow16(i, hh) - qt * 32 - r]; sacc[kt][i] = sv; m = fmaxf(m, sv); } }
            m = fmaxf(m, __shfl_xor(m, 32));
            float lsum = 0.f;
#pragma unroll
            for (int kt = 0; kt < 6; ++kt) if (kt < nkt) {
#pragma unroll
                for (int i = 0; i < 16; ++i) { const float p = __expf(sacc[kt][i] - m); sacc[kt][i] = p; lsum += p; } }
            lsum += __shfl_xor(lsum, 32);
            const float inv = 1.0f / (lsum + __expf(sink - m));
            f32x16 oacc[2];
#pragma unroll
            for (int dt = 0; dt < 2; ++dt)
#pragma unroll
                for (int i = 0; i < 16; ++i) oacc[dt][i] = 0.f;
#pragma unroll
            for (int kt = 0; kt < 6; ++kt) if (kt < nkt) {
#pragma unroll
                for (int i = 0; i < 16; ++i) sacc[kt][i] *= inv;
#pragma unroll
                for (int s = 0; s < 2; ++s) { const bf16x8 pf = pack8(sacc[kt], s);
#pragma unroll
                    for (int dt = 0; dt < 2; ++dt) { const bf16x8 vf = vt_frag(L + VT_OFF + (dt * 32 + r) * VT_STRIDE + (kt * 32 + 16 * s + 4 * hh) * 2); oacc[dt] = MFMA32(vf, pf, oacc[dt]); } } }
            bf16* op = oa + row * 2048 + h * 64 + 4 * hh;
#pragma unroll
            for (int dt = 0; dt < 2; ++dt)
#pragma unroll
                for (int gq = 0; gq < 4; ++gq) { v2u wv; wv.x = pk2(oacc[dt][4 * gq], oacc[dt][4 * gq + 1]); wv.y = pk2(oacc[dt][4 * gq + 2], oacc[dt][4 * gq + 3]); *(v2u*)(op + dt * 32 + 8 * gq) = wv; }
        }
        __syncthreads();
    }
}
__device__ __forceinline__ void p2_sb_mfma(Frame& F, int uc, int uG) {
    const bf16* proj = WSP(bf16, WS_PROJ); bf16* ob = WSP(bf16, WS_OAB) + 1024;
    LAS unsigned char* L = F.lds + RING_OFF;
    constexpr int K_OFF = 0, K_STRIDE = 144, VT_OFF = 448 * K_STRIDE, VT_STRIDE = 904, FL_OFF = VT_OFF + 64 * VT_STRIDE;
    static_assert(FL_OFF + 64 <= RING_BYTES && VT_OFF % 16 == 0, "sb LDS map");
    const int w = F.wave, r = F.lane & 31, hh = F.lane >> 5, tid = F.tid;
    const float LOG2E = 1.4426950408889634f, LN2 = 0.6931471805599453f;
    for (int u = uc; u < 512; u += uG) {
        const int b = u >> 8, h = (u >> 4) & 15, qb = u & 15, q0 = qb * 256, tstart = q0 + 32 * w, t = tstart + r;
        const size_t row = (size_t)b * SEQ + t;
        bf16x8 qf[4];
#pragma unroll
        for (int s = 0; s < 4; ++s) qf[s] = *(const bf16x8*)(proj + row * NIN + C_QB + h * 64 + 16 * s + 8 * hh);
        f32x16 oacc[2];
#pragma unroll
        for (int dt = 0; dt < 2; ++dt)
#pragma unroll
            for (int i = 0; i < 16; ++i) oacc[dt][i] = 0.f;
        float R = 0.f; bool done = false;
        int whi = q0 + 256, wlo = q0 >= 192 ? q0 - 192 : 0;
        for (;;) {
            const int nk = whi - wlo; const bf16* kvbase = proj + ((size_t)b * SEQ + wlo) * NIN + h * 64;
#pragma unroll
            for (int j = 0; j < 7; ++j) { const int p = tid + 512 * j;
                if (p < nk * 8) { const int key = p >> 3, c16 = p & 7; const bf16* src = kvbase + (size_t)key * NIN + c16 * 8;
                    *(LAS v4u*)(L + K_OFF + key * K_STRIDE + c16 * 16) = *(const v4u*)(src + C_KB);
                    vt_scatter(L + VT_OFF, VT_STRIDE, c16, key, *(const v4u*)(src + C_VB)); } }
            __syncthreads();
            for (int kb = (whi - 32 < tstart ? whi - 32 : tstart); kb >= wlo && !done; kb -= 32) {
                const int kl = kb - wlo;
                f32x16 sacc;
#pragma unroll
                for (int i = 0; i < 16; ++i) sacc[i] = 0.f;
#pragma unroll
                for (int s = 0; s < 4; ++s) { const bf16x8 kf = *(const LAS bf16x8*)(L + K_OFF + (kl + r) * K_STRIDE + (16 * s + 8 * hh) * 2); sacc = MFMA32(kf, qf[s], sacc); }
                float sp[16];
#pragma unroll
                for (int i = 0; i < 16; ++i) { const float z = sacc[i] * 0.125f; const bool on = (kb + crow16(i, hh)) < t;
                    const float e = __builtin_amdgcn_exp2f(-fabsf(z) * LOG2E);
                    const float spv = fmaxf(z, 0.f) + LN2 * __builtin_amdgcn_logf(1.0f + e);
                    sp[i] = on ? spv : 0.f; sacc[i] = on ? z - spv : -1.0e30f; }
                float gs[4], ot[4];
#pragma unroll
                for (int gq = 0; gq < 4; ++gq) { gs[gq] = (sp[4 * gq] + sp[4 * gq + 1]) + (sp[4 * gq + 2] + sp[4 * gq + 3]); ot[gq] = __shfl_xor(gs[gq], 32); }
                const float ps3 = gs[3] + ot[3], ps2 = gs[2] + ot[2], ps1 = gs[1] + ot[1], ps0 = gs[0] + ot[0];
                float ge[4];
                ge[3] = (hh == 0 ? ot[3] : 0.f); ge[2] = (hh == 0 ? ot[2] : 0.f) + ps3; ge[1] = (hh == 0 ? ot[1] : 0.f) + ps3 + ps2; ge[0] = (hh == 0 ? ot[0] : 0.f) + ps3 + ps2 + ps1;
#pragma unroll
                for (int gq = 0; gq < 4; ++gq) {
                    const float base = R - ge[gq];
                    const float e3 = base, e2 = e3 - sp[4 * gq + 3], e1 = e2 - sp[4 * gq + 2], e0 = e1 - sp[4 * gq + 1];
                    sacc[4 * gq + 3] = __builtin_amdgcn_exp2f((sacc[4 * gq + 3] + e3) * LOG2E); sacc[4 * gq + 2] = __builtin_amdgcn_exp2f((sacc[4 * gq + 2] + e2) * LOG2E);
                    sacc[4 * gq + 1] = __builtin_amdgcn_exp2f((sacc[4 * gq + 1] + e1) * LOG2E); sacc[4 * gq] = __builtin_amdgcn_exp2f((sacc[4 * gq] + e0) * LOG2E); }
                R -= (ps0 + ps1) + (ps2 + ps3);
#pragma unroll
                for (int s = 0; s < 2; ++s) { const bf16x8 pf = pack8(sacc, s);
#pragma unroll
                    for (int dt = 0; dt < 2; ++dt) { const bf16x8 vf = vt_frag(L + VT_OFF + (dt * 32 + r) * VT_STRIDE + (kl + 16 * s + 4 * hh) * 2); oacc[dt] = MFMA32(vf, pf, oacc[dt]); } }
                done = __all(R < -104.0f);
            }
            LAS unsigned* fl = (LAS unsigned*)(L + FL_OFF);
            if (F.lane == 0) fl[w] = done ? 1u : 0u;
            __syncthreads();
            bool alld = true;
#pragma unroll
            for (int i = 0; i < 8; ++i) alld = alld && (fl[i] != 0u);
            __syncthreads();
            if (alld || wlo == 0) break;
            whi = wlo; wlo = whi >= 448 ? whi - 448 : 0;
        }
        bf16* op = ob + row * 2048 + h * 64 + 4 * hh;
#pragma unroll
        for (int dt = 0; dt < 2; ++dt)
#pragma unroll
            for (int gq = 0; gq < 4; ++gq) { v2u wv; wv.x = pk2(oacc[dt][4 * gq], oacc[dt][4 * gq + 1]); wv.y = pk2(oacc[dt][4 * gq + 2], oacc[dt][4 * gq + 3]); *(v2u*)(op + dt * 32 + 8 * gq) = wv; }
    }
}
__device__ __forceinline__ void p_ln(Frame& F, const float* src, const float* g, const float* b, float* dstf, bf16* dstb) {
    const int gw = F.vcu * NWAVES + F.wave, NGW = F.G * NWAVES;
    for (int m = gw; m < T; m += NGW) {
        f32x4 v[8]; row_load(v, src + (size_t)m * D, F.lane);
        ln_row(v, g, b, F.lane);
        if (dstf) row_store_f32(v, dstf + (size_t)m * D, F.lane);
        row_store_bf16(v, dstb + (size_t)m * D, F.lane);
    }
}
__device__ __forceinline__ void p9_ln_router(Frame& F) {
    const float* wr = F.in[18]; const float* br = F.in[19];
    int* tok_e = WSP(int, WS_ROUTE); float* tok_g = WSP(float, WS_ROUTE + 131072); int* tok_pos = WSP(int, WS_ROUTE + 262144);
    float* h2f = WSP(float, WS_H2F);
    LAS float* part = (LAS float*)(F.lds + RING_OFF);
    LAS unsigned* lcnt = (LAS unsigned*)(F.lds + RING_OFF + 32768); LAS unsigned* lbase = lcnt + 32; LAS unsigned* lpe = lcnt + 64;
    if (F.tid < 32) lcnt[F.tid] = 0u;
    __syncthreads();
    const int w = F.wave, e = F.lane & 31, hh = F.lane >> 5;
    for (int u = F.vcu; u < T / 32; u += F.G) {
        const int tok0 = u * 32;
#pragma unroll 1
        for (int q = 0; q < 4; ++q) { const int m = tok0 + 4 * w + q;
            f32x4 v[8]; row_load(v, WSP(float, WS_S1) + (size_t)m * D, F.lane);
            ln_row(v, F.in[16], F.in[17], F.lane);
            row_store_f32(v, h2f + (size_t)m * D, F.lane);
            row_store_bf16(v, WSP(bf16, WS_H2B) + (size_t)m * D, F.lane);
            { unsigned* o8 = WSP(unsigned, WS_XS) + (size_t)m * (D / 4);
#pragma unroll
              for (int j = 0; j < 8; ++j) o8[F.lane + 64 * j] = pk4_fp8(v[j][0], v[j][1], v[j][2], v[j][3]); } }
        __syncthreads();
        f32x16 acc;
#pragma unroll
        for (int i = 0; i < 16; ++i) acc[i] = 0.f;
        const float* ap = h2f + (size_t)(tok0 + e) * D + 256 * w + 4 * hh;
        const float* bp = wr + (size_t)(256 * w + 4 * hh) * NE + e;
#pragma unroll 4
        for (int m = 0; m < 32; ++m) { const f32x4 a4 = *(const f32x4*)(ap + 8 * m);
#pragma unroll
            for (int j = 0; j < 4; ++j) acc = __builtin_amdgcn_mfma_f32_32x32x2f32(a4[j], bp[(size_t)(8 * m + j) * NE], acc, 0, 0, 0); }
#pragma unroll
        for (int i = 0; i < 16; ++i) part[(w * 32 + crow16(i, hh)) * 32 + e] = acc[i];
        __syncthreads();
        const float bias = br[e];
#pragma unroll 1
        for (int q = 0; q < 4; ++q) { const int tl = 4 * w + q, m = tok0 + tl;
            float val = bias;
#pragma unroll
            for (int ww = 0; ww < 8; ++ww) val += part[(ww * 32 + tl) * 32 + e];
            float tv[4]; int ti[4];
#pragma unroll
            for (int p = 0; p < 4; ++p) {
                float bv = val; int bi = e;
#pragma unroll
                for (int off = 1; off < 32; off <<= 1) { const float ov = __shfl_xor(bv, off); const int oi = __shfl_xor(bi, off);
                    const bool take = (ov > bv) || (ov == bv && oi < bi); bv = take ? ov : bv; bi = take ? oi : bi; }
                tv[p] = bv; ti[p] = bi;
                val = (e == bi) ? -3.0e38f : val;
            }
            const float e1 = __expf(tv[1] - tv[0]), e2 = __expf(tv[2] - tv[0]), e3 = __expf(tv[3] - tv[0]);
            const float inv = 1.0f / (1.0f + e1 + e2 + e3);
            if (F.lane < 4) {
                const int my_e = F.lane == 0 ? ti[0] : F.lane == 1 ? ti[1] : F.lane == 2 ? ti[2] : ti[3];
                const float my_g = (F.lane == 0 ? 1.0f : F.lane == 1 ? e1 : F.lane == 2 ? e2 : e3) * inv;
                const unsigned lpos = __hip_atomic_fetch_add((LAS unsigned*)&lcnt[my_e], 1u, __ATOMIC_RELAXED, __HIP_MEMORY_SCOPE_WORKGROUP);
                tok_e[m * 4 + F.lane] = my_e; tok_g[m * 4 + F.lane] = my_g; lpe[tl * 4 + F.lane] = (unsigned)my_e | (lpos << 8);
            } }
        __syncthreads();
        if (F.tid < 32) { const unsigned c = lcnt[F.tid]; lbase[F.tid] = c ? __hip_atomic_fetch_add((unsigned*)(F.ctl + CW_CNT + 64 * F.tid), c, RLX_AGENT) : 0u; }
        __syncthreads();
        if (F.tid < 128) { const unsigned x = lpe[F.tid]; tok_pos[tok0 * 4 + F.tid] = (int)(lbase[x & 255u] + (x >> 8)); }
        if (F.tid < 32) lcnt[F.tid] = 0u;
        __syncthreads();
    }
}
__device__ __forceinline__ void p10_scatter(Frame& F) {
    const int gw = F.vcu * NWAVES + F.wave, NGW = F.G * NWAVES;
    LAS int* poff = (LAS int*)(F.lds + RING_OFF);
    int* tab = WSP(int, WS_TAB);
    LAS int* lc = poff + 40;
    if (F.tid < NE) lc[F.tid] = (int)__hip_atomic_load((unsigned*)(F.ctl + CW_CNT + 64 * F.tid), RLX_AGENT);
    __syncthreads();
    if (F.tid == 0) {
        int acc = 0;
        int nbig = 0, nsml = 0;
        for (int e = 0; e < NE; ++e) { const int c = lc[e]; poff[e] = acc;
            const int nt = (c + 255) >> 8;
            if (blockIdx.x == 0) for (int k = 0; k < nt; ++k) { const int t = (acc >> 8) + k; tab[t] = e;
                if (c - 256 * k > 128) tab[256 + nbig++] = t; else tab[448 + nsml++] = t; }
            acc += nt << 8; }
        poff[32] = acc;
        if (blockIdx.x == 0) { tab[192] = acc >> 8; tab[193] = nbig; for (int k = 0; k < nsml; ++k) tab[256 + nbig + k] = tab[448 + k]; }
    }
    __syncthreads();
    if (blockIdx.x == 0) {
        const int rt = poff[32] >> 8;
        for (int pass = 0; pass < 2; ++pass) { const int nN = pass ? 8 : 16, nwg = rt * nN; int* ul = tab + (pass ? 8192 : 1024);
            for (int L = F.tid; L < nwg; L += NWAVES * 64) {
                const int q = nwg / 8, r8 = nwg % 8, xcd = L % 8, off = L / 8; const int wgid = (xcd < r8 ? xcd * (q + 1) : r8 * (q + 1) + (xcd - r8) * q) + off;
                int e = 0;
                for (int k = 1; k < NE; ++k) e = (wgid >= (poff[k] >> 8) * nN) ? k : e;
                const int first = poff[e] >> 8, re = (poff[e + 1] >> 8) - first, local = wgid - first * nN;
                ul[L] = (first + local % re) | ((e * nN + local / re) << 16); } }
    }
    const int* tok_e = WSP(int, WS_ROUTE); const int* tok_pos = WSP(int, WS_ROUTE + 262144); int* tok_row = WSP(int, WS_ROUTE + 393216);
    int* rowtok = WSP(int, WS_XS + 32 * MiB);
    const int gt = F.vcu * NWAVES * 64 + F.tid, NT = F.G * NWAVES * 64;
    for (int p = gt; p < T * 4; p += NT) { const int e = tok_e[p], row = poff[e] + tok_pos[p]; tok_row[p] = row; rowtok[row] = p >> 2; }
    for (int e = 0; e < NE; ++e) { const int c0 = poff[e] + lc[e], c1 = poff[e + 1]; for (int r = c0 + gt; r < c1; r += NT) rowtok[r] = 0; }
    __syncthreads();
}
__device__ __forceinline__ void p13_combine(Frame& F) {
    const int gw = F.vcu * NWAVES + F.wave, NGW = F.G * NWAVES;
    const float* tok_g = WSP(float, WS_ROUTE + 131072); const int* tok_row = WSP(int, WS_ROUTE + 393216);
    const bf16* yr = WSP(bf16, WS_YR);
    for (int m = gw; m < T; m += NGW) {
        f32x4 v[8]; row_load(v, WSP(float, WS_H2F) + (size_t)m * D, F.lane);
#pragma unroll
        for (int j = 0; j < 8; ++j) v[j] = v[j] * ALPHA;
#pragma unroll
        for (int k = 0; k < 4; ++k) { const float g = tok_g[m * 4 + k]; const v2u* yp = (const v2u*)(yr + (size_t)tok_row[m * 4 + k] * D);
#pragma unroll
            for (int j = 0; j < 8; ++j) { const v2u w = yp[F.lane + 64 * j]; v[j][0] += g * bflo(w.x); v[j][1] += g * bfhi(w.x); v[j][2] += g * bflo(w.y); v[j][3] += g * bfhi(w.y); } }
        ln_row(v, F.in[24], F.in[25], F.lane);
        row_store_f32(v, F.out + (size_t)m * D, F.lane);
    }
}

struct Args { const float* in[26]; float* out; unsigned char* ws; int ph_lo, ph_hi; };
__global__ void __launch_bounds__(NWAVES * 64, 2) mk_fwd(Args args) {
    extern __shared__ __attribute__((aligned(16))) unsigned char lds[];
    Frame F;
    F.lds = (LAS unsigned char*)lds;
    F.MISC = (volatile LAS unsigned*)(F.lds + MISC_OFF);
    F.tid = threadIdx.x; F.lane = F.tid & 63; F.wave = __builtin_amdgcn_readfirstlane(F.tid >> 6);
    F.G = gridDim.x; { const int bx = blockIdx.x; F.vcu = (F.G % 8 == 0) ? (bx % 8) * (F.G / 8) + bx / 8 : bx; }
    F.ws = args.ws; F.out = args.out;
    F.in = args.in;
    F.ctl = (gu32*)(F.ws + WS_CTL);
    for (int u = F.tid; u < (LDS_BYTES - LDSCTL_OFF) / 4; u += NWAVES * 64) ((LAS unsigned*)(F.lds + LDSCTL_OFF))[u] = 0u;
    __syncthreads();
    const int lo = args.ph_lo, hi = args.ph_hi;
    const bool multi = (hi - lo) > 1;
    XcdBarrier bar; bar.bar = (unsigned*)(F.ctl + CW_BAR); bar.x = 0; bar.st = nullptr;
    if (multi) bar = xcd_barrier_post((unsigned*)(F.ctl + CW_BAR), F.MISC + 8);
#ifndef P1_CW
#define P1_CW 18
#endif
#ifndef P11_CW
#define P11_CW 28
#endif
#ifndef REPEAT_MASK
#define REPEAT_MASK 0u
#endif
#ifndef PHMASK
#define PHMASK 0xffffffffu
#endif
#define IN(k) ((((PHMASK) >> (k)) & 1u) && lo <= (k) && (k) < hi)
#define RUN(k, ...) do { if (IN(k)) __VA_ARGS__ if (((REPEAT_MASK >> (k)) & 1u) && IN(k)) __VA_ARGS__ } while (0);
#define SEAM(k) do { if (IN(k) && IN((k) + 1)) xcd_barrier(bar); } while (0)
    const int G = F.G, cidx = (int)blockIdx.x;

    RUN(0, { p0_prologue(F); }) SEAM(0);
    const int xi = cidx & 7, pi = cidx >> 3, per_x = G >> 3;
    RUN(1, {
        const bool split = (G % 8 == 0) && per_x > P1_CW;
        if (!split) { cvt_role_p1(F, F.vcu * NWAVES + F.wave, G * NWAVES); if (multi) xcd_barrier(bar); }
        if (!split || pi < P1_CW) {
            pg8::Gemm g{(const bf16*)F.ws, (const bf16*)F.ws, T + 512, NIN + 4096, D}; blk::SchedP1 S; S.init(split ? P1_CW * 8 : G, split ? pi * 8 + xi : cidx);
            blk::EpiProj E{F.ws, F.in[6]};
            pg8::gemm_phase<blk::EpiProj, blk::SchedP1, true, true>(F.lds + RING_OFF, g, S, E);
            if (split) {
                VM_WAIT(); __syncthreads();
                if (F.tid == 0) {
                    __builtin_amdgcn_fence(__ATOMIC_RELEASE, "agent"); VM_WAIT();
                    gu32* cnt = F.ctl + CW_SUB; const unsigned want = (unsigned)(P1_CW * 8);
                    __hip_atomic_fetch_add(cnt, 1u, RLX_AGENT);
                    unsigned sp = 0;
                    while (__hip_atomic_load(cnt, RLX_AGENT) < want) { __builtin_amdgcn_s_sleep(2);
                        if ((++sp & 255u) == 0u) { if (__hip_atomic_load(F.ctl + CW_TMO, RLX_AGENT)) break; if (sp > (1u << 20)) { __hip_atomic_store(F.ctl + CW_TMO, 1u, RLX_AGENT); break; } } }
                    __builtin_amdgcn_fence(__ATOMIC_ACQUIRE, "agent"); VM_WAIT();
                }
                __syncthreads();
                p2_swa_mfma(F, xi * P1_CW + pi, P1_CW * 8); p2_sb_mfma(F, xi * P1_CW + pi, P1_CW * 8);
            }
        } else cvt_role_p1(F, ((pi - P1_CW) * 8 + xi) * NWAVES + F.wave, (per_x - P1_CW) * 8 * NWAVES);
    }) SEAM(1);
    if (!((G % 8 == 0) && per_x > P1_CW)) { RUN(2, { p2_swa_mfma(F, F.vcu, G); p2_sb_mfma(F, F.vcu, G); }) SEAM(2); }
    RUN(3, {
        pg8::Gemm g{WSP(bf16, WS_OAB), WSP(bf16, WS_BTAB), T, D, D}; pg8::StaticOrder S; S.init(T, D, G, cidx);
        blk::EpiGate E{WSP(bf16, WS_PROJ), WSP(bf16, WS_GG)};
        pg8::gemm_phase<blk::EpiGate, pg8::StaticOrder, true, true, false, false, true>(F.lds + RING_OFF, g, S, E);
    }) SEAM(3);
    RUN(4, {
        pg8::Gemm g{WSP(bf16, WS_GG), WSP(bf16, WS_BTMIX), T, D, D}; pg8::StaticOrder S; S.init(T, D, G, cidx);
        blk::EpiRes E{WSP(bf16, WS_H0B), WSP(float, WS_S1)};
        pg8::gemm_phase<blk::EpiRes, pg8::StaticOrder, true, true>(F.lds + RING_OFF, g, S, E);
    }) SEAM(4);
    RUN(5, { p_ln(F, WSP(float, WS_S1), F.in[11], F.in[12], nullptr, WSP(bf16, WS_H1B)); }) SEAM(5);
    RUN(6, {
        pg8::Gemm g{WSP(bf16, WS_H1B), WSP(bf16, WS_BTXQ), T, D, D}; pg8::StaticOrder S; S.init(T, D, G, cidx);
        blk::EpiBf16B E{WSP(bf16, WS_QX), D, nullptr, 0x7fffffff, 31, 0, 1.0f};
        pg8::gemm_phase<blk::EpiBf16B, pg8::StaticOrder, true, true>(F.lds + RING_OFF, g, S, E);
    }) SEAM(6);
    RUN(7, { p7_cross_mfma(F); }) SEAM(7);
    RUN(8, {
        pg8::Gemm g{WSP(bf16, WS_OX), WSP(bf16, WS_BTXO), T, D, D}; pg8::StaticOrder S; S.init(T, D, G, cidx);
        blk::EpiRes E{WSP(bf16, WS_H1B), WSP(float, WS_S1)};
        pg8::gemm_phase<blk::EpiRes, pg8::StaticOrder, true, true>(F.lds + RING_OFF, g, S, E);
    }) SEAM(8);
    RUN(9, { p9_ln_router(F); }) SEAM(9);
    RUN(10, { p10_scatter(F); }) SEAM(10);
    RUN(11, {
        pg8::Gemm g{WSP(bf16, WS_XS), WSP(bf16, WS_BTUP), RMAX, NE * 4096, D}; blk::SchedMoE S; S.init(WSP(int, WS_TAB), 16, G, cidx, (LAS int*)(F.lds + MISC_OFF + 256), F.tid, WSP(int, WS_XS + 32 * MiB));
        blk::EpiSwiGLU E{WSP(unsigned char, WS_ACT), F.in[21]};
        pg8::gemm_phase<blk::EpiSwiGLU, blk::SchedMoE, true, true, false, true, false, true>(F.lds + RING_OFF, g, S, E);
    }) SEAM(11);
    RUN(12, {
        pg8::Gemm g{WSP(bf16, WS_ACT), WSP(bf16, WS_BTDN), RMAX, NE * 2048, FF}; blk::SchedMoE S; S.init(WSP(int, WS_TAB), 8, G, cidx, (LAS int*)(F.lds + MISC_OFF + 256), F.tid);
        blk::EpiBf16B E{WSP(bf16, WS_YR), D, F.in[23], 7, 3, 2048, W8_INV};
        pg8::gemm_phase<blk::EpiBf16B, blk::SchedMoE, true, true, false, true>(F.lds + RING_OFF, g, S, E);
    }) SEAM(12);
    RUN(13, { p13_combine(F); })
#undef IN
#undef SEAM
}

extern "C" void kernel_launch(void* const* d_in, const int* in_sizes, int n_in, void* d_out, int out_size, void* d_ws, size_t ws_size, hipStream_t stream) {
    static int grid = 0;
    if (grid == 0) {
        if (n_in != 26 || out_size != T * D || ws_size < WS_END) { fprintf(stderr, "kernel_launch: unexpected shapes: n_in %d out %d ws %zu (need %zu)\n", n_in, out_size, ws_size, (size_t)WS_END); grid = -1; return; }
        int dev = 0, cus = 0, per_cu = 0;
        if (hipGetDevice(&dev) != hipSuccess || hipDeviceGetAttribute(&cus, hipDeviceAttributeMultiprocessorCount, dev) != hipSuccess) { grid = -1; return; }
        if (hipFuncSetAttribute((const void*)mk_fwd, hipFuncAttributeMaxDynamicSharedMemorySize, LDS_BYTES) != hipSuccess) { fprintf(stderr, "kernel_launch: hipFuncSetAttribute failed\n"); grid = -1; return; }
        if (hipOccupancyMaxActiveBlocksPerMultiprocessor(&per_cu, (const void*)mk_fwd, NWAVES * 64, LDS_BYTES) != hipSuccess || per_cu < 1)
            fprintf(stderr, "kernel_launch: occupancy query reports %d workgroups per CU\n", per_cu);
        (void)hipGetLastError();
        grid = cus;
    }
    if (grid < 0) return;
    if (hipMemsetAsync((char*)d_ws + WS_CTL, 0, CTL_ZERO_BYTES, stream) != hipSuccess) return;
    Args a{};
    for (int i = 0; i < 26; ++i) a.in[i] = (const float*)d_in[i];
    a.out = (float*)d_out; a.ws = (unsigned char*)d_ws;
#if MK_ONE_LAUNCH
    a.ph_lo = 0; a.ph_hi = NPHASE;
    hipLaunchKernelGGL(mk_fwd, dim3(grid), dim3(NWAVES * 64), LDS_BYTES, stream, a);
#else
    for (int ph = 0; ph < NPHASE; ++ph) { a.ph_lo = ph; a.ph_hi = ph + 1;
        hipLaunchKernelGGL(mk_fwd, dim3(grid), dim3(NWAVES * 64), LDS_BYTES, stream, a); }
#endif
}
```
